# Optimizing an MI355X kernel written in HIP

```python
import jax, jax.numpy as jnp
from jax import lax
import numpy as np

D_MODEL = 2048
BATCH = 8
SEQ = 4096
DEPTH = 4
DEC_BATCH = 4
DEC_SEQ = 8192
PAST_LEN = 128

RET_HEADS = 8
RET_HEAD_DIM = 128
RET_WIDTH = RET_HEADS * RET_HEAD_DIM
LRU_BLOCKS = 8
LRU_BLOCK = 128
LRU_WIDTH = LRU_BLOCKS * LRU_BLOCK
MIX_WIDTH = RET_WIDTH + LRU_WIDTH
IN_WIDTH = 4 * RET_WIDTH + 2 * LRU_WIDTH
CONV_WIDTH = 4
CONV_PAD_LEFT = 2
CONV_PAD_RIGHT = CONV_WIDTH - 1 - CONV_PAD_LEFT
LRU_C = 8.0
D_FF = -(-8 * D_MODEL // (3 * 256)) * 256
CHUNK = 128
ROPE_BASE = 10000.0
EPS = 1e-6

kernel_name = "hymba_retnet_rglru_bidir_encoder"


def _rmsnorm(x, gain):
    xf = x.astype(jnp.float32)
    y = xf * lax.rsqrt(jnp.mean(xf * xf, axis=-1, keepdims=True) + EPS)
    return (y * gain.astype(jnp.float32)).astype(x.dtype)


def _rope(x):
    S, d = x.shape[1], x.shape[-1]
    inv = ROPE_BASE ** (-jnp.arange(0, d, 2, dtype=jnp.float32) / d)
    ang = jnp.arange(S, dtype=jnp.float32)[:, None] * inv[None, :]
    cos = jnp.cos(ang)[None, :, None, :].astype(x.dtype)
    sin = jnp.sin(ang)[None, :, None, :].astype(x.dtype)
    x1, x2 = x[..., : d // 2], x[..., d // 2:]
    return jnp.concatenate([x1 * cos - x2 * sin, x2 * cos + x1 * sin], axis=-1)


def _retention(q, k, v):
    B, S, H, dk = q.shape
    dv = v.shape[-1]
    N = S // CHUNK
    dt = q.dtype
    q = q.reshape(B, N, CHUNK, H, dk)
    k = k.reshape(B, N, CHUNK, H, dk)
    v = v.reshape(B, N, CHUNK, H, dv)
    log_g = jnp.log1p(-(2.0 ** (-5.0 - jnp.arange(H, dtype=jnp.float32))))
    pos = jnp.arange(CHUNK, dtype=jnp.float32)
    d_intra = jnp.exp(log_g[:, None, None] * jnp.abs(pos[:, None] - pos[None, :])[None]).astype(dt)
    scores = jnp.einsum('bnihd,bnjhd->bnhij', q, k) * d_intra
    y = jnp.einsum('bnhij,bnjhe->bnihe', scores, v)
    k_f = k * jnp.exp(log_g[None, :] * (CHUNK - 1 - pos)[:, None]).astype(dt)[:, :, None]
    k_b = k * jnp.exp(log_g[None, :] * pos[:, None]).astype(dt)[:, :, None]
    kv_f = jnp.einsum('bnjhd,bnjhe->nbhde', k_f, v)
    kv_b = jnp.einsum('bnjhd,bnjhe->nbhde', k_b, v)
    g_chunk = jnp.exp(log_g * CHUNK).astype(dt)[None, :, None, None]

    def step(state, kv):
        return state * g_chunk + kv, state

    zero = jnp.zeros((B, H, dk, dv), dt)
    _, s_f = lax.scan(step, zero, kv_f)
    _, s_b = lax.scan(step, zero, kv_b, reverse=True)
    q_f = q * jnp.exp(log_g[None, :] * (pos + 1.0)[:, None]).astype(dt)[:, :, None]
    q_b = q * jnp.exp(log_g[None, :] * (CHUNK - pos)[:, None]).astype(dt)[:, :, None]
    y = (y + jnp.einsum('bnihd,nbhde->bnihe', q_f, s_f)
         + jnp.einsum('bnihd,nbhde->bnihe', q_b, s_b))
    return y.reshape(B, S, H, dv)


def _centred_conv(u, w, bias):
    S = u.shape[1]
    up = jnp.pad(u, ((0, 0), (CONV_PAD_LEFT, CONV_PAD_RIGHT), (0, 0)))
    return bias + sum(up[:, t:t + S] * w[t] for t in range(CONV_WIDTH))


def _rg_lru_terms(u, w_a, b_a, w_x, b_x, lam):
    B, S, W = u.shape
    ub = u.reshape(B, S, LRU_BLOCKS, LRU_BLOCK)
    r = jax.nn.sigmoid(jnp.einsum('bsgi,gij->bsgj', ub, w_a).reshape(B, S, W) + b_a)
    i = jax.nn.sigmoid(jnp.einsum('bsgi,gij->bsgj', ub, w_x).reshape(B, S, W) + b_x)
    log_a = -LRU_C * r * jax.nn.softplus(-lam)
    a = jnp.exp(log_a)
    b = jnp.sqrt(-jnp.expm1(2.0 * log_a)) * (i * u)
    return a, b


def _combine(e1, e2):
    a1, b1 = e1
    a2, b2 = e2
    return a1 * a2, a2 * b1 + b2


def _linear_scan(a, b, reverse):
    if reverse:
        a, b = jnp.flip(a, 1), jnp.flip(b, 1)
    _, h = lax.associative_scan(_combine, (a, b), axis=1)
    return jnp.flip(h, 1) if reverse else h


def _layer(x, norm_pre_mix, w_in, ret_norm, conv_w, conv_b,
           lru_wa_fwd, lru_ba_fwd, lru_wx_fwd, lru_bx_fwd, lru_lam_fwd,
           lru_wa_bwd, lru_ba_bwd, lru_wx_bwd, lru_bx_bwd, lru_lam_bwd,
           lru_norm, w_out, norm_post_mix, norm_pre_ffn, w_gate, w_up, w_down, norm_post_ffn):
    B, S, _ = x.shape
    h = _rmsnorm(x, norm_pre_mix)
    proj = h @ w_in
    q, k, v, g, u_x, u_y = jnp.split(
        proj, [RET_WIDTH, 2 * RET_WIDTH, 3 * RET_WIDTH, 4 * RET_WIDTH, 4 * RET_WIDTH + LRU_WIDTH], axis=-1)
    q = _rope(q.reshape(B, S, RET_HEADS, RET_HEAD_DIM))
    k = _rope(k.reshape(B, S, RET_HEADS, RET_HEAD_DIM)) * (RET_HEAD_DIM ** -0.5)
    v = v.reshape(B, S, RET_HEADS, RET_HEAD_DIM)
    ret = _rmsnorm(_retention(q, k, v), ret_norm).reshape(B, S, RET_WIDTH)
    ret = jax.nn.silu(g) * ret
    uc = _centred_conv(u_x, conv_w, conv_b)
    a_f, b_f = _rg_lru_terms(uc, lru_wa_fwd, lru_ba_fwd, lru_wx_fwd, lru_bx_fwd, lru_lam_fwd)
    a_b, b_b = _rg_lru_terms(uc, lru_wa_bwd, lru_ba_bwd, lru_wx_bwd, lru_bx_bwd, lru_lam_bwd)
    lru = _linear_scan(a_f, b_f, False) + _linear_scan(a_b, b_b, True)
    lru = _rmsnorm(lru, lru_norm) * jax.nn.gelu(u_y)
    mix = jnp.concatenate([ret, lru], axis=-1) @ w_out
    x = x + _rmsnorm(mix, norm_post_mix)
    h = _rmsnorm(x, norm_pre_ffn)
    f = (jax.nn.silu(h @ w_gate) * (h @ w_up)) @ w_down
    return x + _rmsnorm(f, norm_post_ffn)


def _trunk(x, params):
    for l in range(DEPTH):
        x = _layer(x, *[p[l] for p in params])
    return x


def setup_inputs(seed: int = 0) -> dict:
    key = jax.random.key(seed)
    ks = jax.random.split(key, 32)
    f32 = jnp.float32
    nrm = lambda k, shape, s: jax.random.normal(k, shape, f32) * s
    gain = lambda k, shape: 1.0 + 0.05 * jax.random.normal(k, shape, f32)

    def lam_init(k):
        u = jax.random.uniform(k, (DEPTH, LRU_WIDTH), f32, minval=0.9, maxval=0.999)
        a = u ** (1.0 / LRU_C)
        return jnp.log(a) - jnp.log1p(-a)

    return {
        "x_prompt": jax.random.normal(ks[0], (BATCH, SEQ, D_MODEL), f32),
        "x_sample": jax.random.normal(ks[1], (DEC_BATCH, DEC_SEQ, D_MODEL), f32),
        "norm_pre_mix": gain(ks[2], (DEPTH, D_MODEL)),
        "w_in": nrm(ks[3], (DEPTH, D_MODEL, IN_WIDTH), D_MODEL ** -0.5),
        "ret_norm": gain(ks[4], (DEPTH, RET_HEADS, RET_HEAD_DIM)),
        "conv_w": nrm(ks[5], (DEPTH, CONV_WIDTH, LRU_WIDTH), CONV_WIDTH ** -0.5),
        "conv_b": nrm(ks[6], (DEPTH, LRU_WIDTH), 0.01),
        "lru_wa_fwd": nrm(ks[7], (DEPTH, LRU_BLOCKS, LRU_BLOCK, LRU_BLOCK), LRU_BLOCK ** -0.5),
        "lru_ba_fwd": nrm(ks[8], (DEPTH, LRU_WIDTH), 0.01),
        "lru_wx_fwd": nrm(ks[9], (DEPTH, LRU_BLOCKS, LRU_BLOCK, LRU_BLOCK), LRU_BLOCK ** -0.5),
        "lru_bx_fwd": nrm(ks[10], (DEPTH, LRU_WIDTH), 0.01),
        "lru_lam_fwd": lam_init(ks[11]),
        "lru_wa_bwd": nrm(ks[12], (DEPTH, LRU_BLOCKS, LRU_BLOCK, LRU_BLOCK), LRU_BLOCK ** -0.5),
        "lru_ba_bwd": nrm(ks[13], (DEPTH, LRU_WIDTH), 0.01),
        "lru_wx_bwd": nrm(ks[14], (DEPTH, LRU_BLOCKS, LRU_BLOCK, LRU_BLOCK), LRU_BLOCK ** -0.5),
        "lru_bx_bwd": nrm(ks[15], (DEPTH, LRU_WIDTH), 0.01),
        "lru_lam_bwd": lam_init(ks[16]),
        "lru_norm": gain(ks[17], (DEPTH, LRU_WIDTH)),
        "w_out": nrm(ks[18], (DEPTH, MIX_WIDTH, D_MODEL), MIX_WIDTH ** -0.5),
        "norm_post_mix": gain(ks[19], (DEPTH, D_MODEL)),
        "norm_pre_ffn": gain(ks[20], (DEPTH, D_MODEL)),
        "w_gate": nrm(ks[21], (DEPTH, D_MODEL, D_FF), D_MODEL ** -0.5),
        "w_up": nrm(ks[22], (DEPTH, D_MODEL, D_FF), D_MODEL ** -0.5),
        "w_down": nrm(ks[23], (DEPTH, D_FF, D_MODEL), D_FF ** -0.5),
        "norm_post_ffn": gain(ks[24], (DEPTH, D_MODEL)),
    }


def reference(x_prompt, x_sample, norm_pre_mix, w_in, ret_norm, conv_w, conv_b,
              lru_wa_fwd, lru_ba_fwd, lru_wx_fwd, lru_bx_fwd, lru_lam_fwd,
              lru_wa_bwd, lru_ba_bwd, lru_wx_bwd, lru_bx_bwd, lru_lam_bwd,
              lru_norm, w_out, norm_post_mix, norm_pre_ffn, w_gate, w_up, w_down, norm_post_ffn):
    params = (norm_pre_mix, w_in, ret_norm, conv_w, conv_b,
              lru_wa_fwd, lru_ba_fwd, lru_wx_fwd, lru_bx_fwd, lru_lam_fwd,
              lru_wa_bwd, lru_ba_bwd, lru_wx_bwd, lru_bx_bwd, lru_lam_bwd,
              lru_norm, w_out, norm_post_mix, norm_pre_ffn, w_gate, w_up, w_down, norm_post_ffn)
    y_prompt = _trunk(x_prompt, params)
    y_sample = _trunk(x_sample, params)
    return (y_prompt, y_sample)
```

```cpp
#include <hip/hip_runtime.h>
#include <cstdio>
#include <cstdint>

#ifndef MK_ONE_LAUNCH
#define MK_ONE_LAUNCH 1
#endif

namespace pg8 {
#define PG8_LAS __attribute__((address_space(3)))
typedef unsigned short bf16_t;
typedef short bf16x8 __attribute__((ext_vector_type(8)));
typedef float f32x4 __attribute__((ext_vector_type(4)));
typedef unsigned u32x4 __attribute__((ext_vector_type(4)));
constexpr int BM = 256, BK = 64, HALF = 128, HTB = HALF * BK * 2  , STAGE_BYTES = 8 * HTB, NXCD = 8, WGM = 8;

__host__ __device__ __forceinline__ int lds_byte(int r, int c) { const int st = (r >> 4) * 2 + (c >> 5), rr = r & 15, cc = c & 31, ob = rr * 64 + cc * 2; return st * 1024 + (ob ^ (((ob >> 9) & 1) << 5)); }
__host__ __device__ __forceinline__ void stage_rc(int b, int& R, int& C) { const int st = b / 1024, sb = b % 1024, swz = sb ^ (((sb >> 9) & 1) << 5); R = (st >> 1) * 16 + swz / 64; C = (st & 1) * 32 + (swz % 64) / 2; }
__host__ __device__ __forceinline__ int perm32(int rho) { const int n = rho >> 4, i = rho & 15; return 8 * (i >> 2) + 4 * n + (i & 3); }

struct Unit { int pm, pn; };
struct Gemm { const bf16_t* A; const bf16_t* Bt; int M, N, K; };

struct StaticOrder {
    int nM, nN, nwg, G, c, wgm;
    __host__ __device__ void init(int M, int N, int G_, int c_, int wgm_ = WGM) { nM = M / BM; nN = N / BM; nwg = nM * nN; G = G_; c = c_; wgm = wgm_; }
    __host__ __device__ bool next(int i, Unit& u) const {
        const long L = (long)i * G + c; if (L >= nwg) return false;
        int wgid = (int)L; { const int q = nwg / NXCD, r = nwg % NXCD, xcd = wgid % NXCD, off = wgid / NXCD; wgid = (xcd < r ? xcd * (q + 1) : r * (q + 1) + (xcd - r) * q) + off; }
        const int nig = wgm * nN, gid = wgid / nig, fm = gid * wgm, gsz = (nM - fm) < wgm ? (nM - fm) : wgm;
        u.pm = fm + ((wgid % nig) % gsz); u.pn = (wgid % nig) / gsz; return true;
    }
    __device__ __forceinline__ void a_ready(const Unit&) const {}
    __device__ __forceinline__ void done(const Unit&) const {}
};

typedef float f32x2_ __attribute__((ext_vector_type(2)));
typedef __bf16 bf16x2_ __attribute__((ext_vector_type(2)));
__device__ __forceinline__ unsigned cvt_pk_bf16(float lo, float hi) { const f32x2_ v = {lo, hi}; const bf16x2_ r = __builtin_convertvector(v, bf16x2_); return __builtin_bit_cast(unsigned, r); }

struct EpiBf16 {
    static constexpr bool PERM = true, AFTER_DRAIN = false;
    bf16_t* O; int ldc;
    __device__ __forceinline__ void operator()(const f32x4 (&acc)[2][2][4][2], const Unit& u, int wr, int wc, int fr, int fq) const {
        const int row0 = u.pm * BM + wr * 64 + fr, col0 = u.pn * BM + wc * 32 + 8 * fq;
#pragma unroll
        for (int ai = 0; ai < 2; ++ai)
#pragma unroll
            for (int m = 0; m < 4; ++m) { bf16_t* rowp = O + (size_t)(row0 + ai * HALF + m * 16) * ldc + col0;
#pragma unroll
                for (int bj = 0; bj < 2; ++bj) { const f32x4 v0 = acc[ai][bj][m][0], v1 = acc[ai][bj][m][1];
                    u32x4 w; w.x = cvt_pk_bf16(v0[0], v0[1]); w.y = cvt_pk_bf16(v0[2], v0[3]); w.z = cvt_pk_bf16(v1[0], v1[1]); w.w = cvt_pk_bf16(v1[2], v1[3]);
                    *(u32x4*)(rowp + bj * HALF) = w; } }
    }
};
struct EpiProj {
    static constexpr bool PERM = true, AFTER_DRAIN = false;
    bf16_t* O; const float* rstat; const float* cosT; const float* sinT; int smask;
    __device__ __forceinline__ void operator()(const f32x4 (&acc)[2][2][4][2], const Unit& u, int wr, int wc, int fr, int fq) const {
        const int row0 = u.pm * BM + wr * 64 + fr, col0 = u.pn * BM + wc * 32 + 8 * fq;
        if (u.pn < 8) {
            const int ti = 16 * wc + 4 * fq;
            const f32x4 cd = *(const f32x4*)(cosT + 16 * 64 + ti), sd = *(const f32x4*)(sinT + 16 * 64 + ti);
#pragma unroll
            for (int ai = 0; ai < 2; ++ai) { const int pos = (row0 + ai * HALF) & smask;
                f32x4 c4 = *(const f32x4*)(cosT + pos * 64 + ti), s4 = *(const f32x4*)(sinT + pos * 64 + ti);
#pragma unroll
                for (int m = 0; m < 4; ++m) { const int row = row0 + ai * HALF + m * 16; const float rs = rstat[row];
                    bf16_t* rowp = O + (size_t)row * 6144 + col0;
#pragma unroll
                    for (int bj = 0; bj < 2; ++bj) { const f32x4 x1 = acc[ai][bj][m][0], x2 = acc[ai][bj][m][1];
                        const f32x4 v0 = (x1 * c4 - x2 * s4) * rs, v1 = (x2 * c4 + x1 * s4) * rs;
                        u32x4 w; w.x = cvt_pk_bf16(v0[0], v0[1]); w.y = cvt_pk_bf16(v0[2], v0[3]); w.z = cvt_pk_bf16(v1[0], v1[1]); w.w = cvt_pk_bf16(v1[2], v1[3]);
                        *(u32x4*)(rowp + bj * HALF) = w; }
                    if (m < 3) { const f32x4 cn = c4 * cd - s4 * sd, sn = s4 * cd + c4 * sd; c4 = cn; s4 = sn; } } }
        } else {
#pragma unroll
            for (int ai = 0; ai < 2; ++ai)
#pragma unroll
                for (int m = 0; m < 4; ++m) { const int row = row0 + ai * HALF + m * 16; const float rs = rstat[row];
                    bf16_t* rowp = O + (size_t)row * 6144 + col0;
#pragma unroll
                    for (int bj = 0; bj < 2; ++bj) { const f32x4 v0 = acc[ai][bj][m][0] * rs, v1 = acc[ai][bj][m][1] * rs;
                        u32x4 w; w.x = cvt_pk_bf16(v0[0], v0[1]); w.y = cvt_pk_bf16(v0[2], v0[3]); w.z = cvt_pk_bf16(v1[0], v1[1]); w.w = cvt_pk_bf16(v1[2], v1[3]);
                        *(u32x4*)(rowp + bj * HALF) = w; } }
        }
    }
};
struct EpiSwiGLU {
    static constexpr bool PERM = true, AFTER_DRAIN = false;
    bf16_t* O; const float* rstat;
    __device__ __forceinline__ void operator()(const f32x4 (&acc)[2][2][4][2], const Unit& u, int wr, int wc, int fr, int fq) const {
        const int row0 = u.pm * BM + wr * 64 + fr, col0 = u.pn * HALF + wc * 32 + 8 * fq;
#pragma unroll
        for (int ai = 0; ai < 2; ++ai)
#pragma unroll
            for (int m = 0; m < 4; ++m) { const int row = row0 + ai * HALF + m * 16; const float rs = rstat[row];
                float o[8];
#pragma unroll
                for (int n = 0; n < 2; ++n)
#pragma unroll
                    for (int j = 0; j < 4; ++j) { const float g = acc[ai][0][m][n][j] * rs, up = acc[ai][1][m][n][j] * rs;
                        o[n * 4 + j] = g * __builtin_amdgcn_rcpf(1.0f + __builtin_amdgcn_exp2f(-1.44269504089f * g)) * up; }
                u32x4 w; w.x = cvt_pk_bf16(o[0], o[1]); w.y = cvt_pk_bf16(o[2], o[3]); w.z = cvt_pk_bf16(o[4], o[5]); w.w = cvt_pk_bf16(o[6], o[7]);
                *(u32x4*)(O + (size_t)row * 5632 + col0) = w; }
    }
};

template <class Epi, class Sched, bool ALIGN_EPI = false, bool SP2 = false>
__device__ __forceinline__ void gemm_phase(PG8_LAS unsigned char* lds, const Gemm g, const Sched& S, const Epi& E, int wave_in) {
    int tid_ = wave_in * 64 + (int)__builtin_amdgcn_mbcnt_hi(~0u, __builtin_amdgcn_mbcnt_lo(~0u, 0u)); asm volatile("" : "+v"(tid_));
    const int tid = tid_, wid = __builtin_amdgcn_readfirstlane(tid >> 6), lane = tid & 63, wr = wid >> 2, wc = wid & 3, fr = lane & 15, fq = lane >> 4;
    const int K = g.K, nt = K / BK;
    unsigned voffA[2], voffB[2];
#pragma unroll
    for (int i = 0; i < 2; ++i) { int R, C; stage_rc(tid * 16 + i * 8192, R, C); const int Rb = Epi::PERM ? ((R & ~31) + perm32(R & 31)) : R;
        voffA[i] = (unsigned)(R * K + C) * 2u; voffB[i] = (unsigned)(Rb * K + C) * 2u; }
    const size_t kstep = (size_t)(BK * 2);
    const size_t hstep = (size_t)HALF * K * 2;
    const size_t tstep = 2 * hstep;
    const unsigned ldsw = (unsigned)wid * 1024u;
    const int aoff = lds_byte(wr * 64 + fr, fq * 8), boff = lds_byte(wc * 32 + fr, fq * 8);
#define PG8_SA(b, h) (((b) * 2 + (h)) * HTB)
#define PG8_SB(b, h) ((4 + (b) * 2 + (h)) * HTB)
#define PG8_STAGE(bufoff, gbase, voff) do { _Pragma("unroll") for (int _i = 0; _i < 2; ++_i) \
        __builtin_amdgcn_global_load_lds((const unsigned*)((const char*)(gbase) + (voff)[_i]), (PG8_LAS unsigned*)(lds + (bufoff) + ldsw + _i * 8192), 16, 0, 0); } while (0)
#define PG8_LDA(dst, b, h) do { _Pragma("unroll") for (int m = 0; m < 4; ++m) _Pragma("unroll") for (int k = 0; k < 2; ++k) dst[m][k] = *(const PG8_LAS bf16x8*)(lds + PG8_SA(b, h) + aoff + m * 2048 + k * 1024); } while (0)
#define PG8_LDB(dst, b, h) do { _Pragma("unroll") for (int n = 0; n < 2; ++n) _Pragma("unroll") for (int k = 0; k < 2; ++k) dst[n][k] = *(const PG8_LAS bf16x8*)(lds + PG8_SB(b, h) + boff + n * 2048 + k * 1024); } while (0)
#define PG8_MMA(ai, bj, At, Bt) do { __builtin_amdgcn_s_setprio(1); _Pragma("unroll") for (int m = 0; m < 4; ++m) _Pragma("unroll") for (int n = 0; n < 2; ++n) _Pragma("unroll") for (int k = 0; k < 2; ++k) \
        acc[ai][bj][m][n] = __builtin_amdgcn_mfma_f32_16x16x32_bf16(Bt[n][k], At[m][k], acc[ai][bj][m][n], 0, 0, 0); __builtin_amdgcn_s_setprio(0); } while (0)
#define PG8_WAIT_V(n) asm volatile("s_waitcnt vmcnt(" #n ")" ::: "memory")
#define PG8_WAIT_L(n) asm volatile("s_waitcnt lgkmcnt(" #n ")" ::: "memory")
#define PG8_BAR __builtin_amdgcn_s_barrier()
#define PG8_SCHED __builtin_amdgcn_sched_barrier(0)
    Unit cur, nxt; int ui = 0;
    if (!S.next(0, cur)) return;
    f32x4 acc[2][2][4][2];
#pragma unroll
    for (int a = 0; a < 2; ++a)
#pragma unroll
        for (int b = 0; b < 2; ++b)
#pragma unroll
            for (int m = 0; m < 4; ++m)
#pragma unroll
                for (int n = 0; n < 2; ++n) acc[a][b][m][n] = (f32x4){0.f, 0.f, 0.f, 0.f};
    bf16x8 At[4][2], B0[2][2], B1[2][2];
    const char* cA = (const char*)g.A + (size_t)cur.pm * tstep; const char* cB = (const char*)g.Bt + (size_t)cur.pn * tstep;
    S.a_ready(cur);
    if constexpr (SP2) {
        PG8_STAGE(PG8_SB(0, 0), cB, voffB); PG8_STAGE(PG8_SB(0, 1), cB + hstep, voffB); PG8_STAGE(PG8_SA(0, 0), cA, voffA); PG8_STAGE(PG8_SA(0, 1), cA + hstep, voffA);
        if (wr == 1) PG8_BAR;
        PG8_WAIT_V(2); PG8_BAR;
        PG8_STAGE(PG8_SB(1, 0), cB + kstep, voffB); PG8_STAGE(PG8_SA(1, 0), cA + kstep, voffA); PG8_STAGE(PG8_SB(1, 1), cB + hstep + kstep, voffB);
        PG8_WAIT_V(6); PG8_BAR;
    } else {
        PG8_STAGE(PG8_SB(0, 0), cB, voffB); PG8_STAGE(PG8_SA(0, 0), cA, voffA); PG8_STAGE(PG8_SB(0, 1), cB + hstep, voffB); PG8_STAGE(PG8_SA(0, 1), cA + hstep, voffA);
        if (wr == 1) PG8_BAR;
        PG8_WAIT_V(4); PG8_BAR;
        PG8_STAGE(PG8_SB(1, 0), cB + kstep, voffB); PG8_STAGE(PG8_SA(1, 0), cA + kstep, voffA); PG8_STAGE(PG8_SB(1, 1), cB + hstep + kstep, voffB);
        PG8_WAIT_V(6); PG8_BAR;
    }
    for (;;) {
        const bool has_next = S.next(ui + 1, nxt);
        const char* nA = has_next ? (const char*)g.A + (size_t)nxt.pm * tstep : cA; const char* nB = has_next ? (const char*)g.Bt + (size_t)nxt.pn * tstep : cB;
        for (int t = 0; t < nt; t += 2) {
            const bool last = (t == nt - 2);
            const char* a1 = cA + (size_t)(t + 1) * kstep;
            const char* a2 = last ? nA : cA + (size_t)(t + 2) * kstep; const char* b2 = last ? nB : cB + (size_t)(t + 2) * kstep;
            const char* a3 = a2 + kstep; const char* b3 = b2 + kstep;
            if (last && has_next) S.a_ready(nxt);
            if constexpr (SP2) {
            PG8_LDB(B0, 0, 0); PG8_LDB(B1, 0, 1); PG8_SCHED; PG8_LDA(At, 0, 0); PG8_STAGE(PG8_SA(1, 1), a1 + hstep, voffA);
            PG8_WAIT_V(8); PG8_WAIT_L(0); PG8_BAR; PG8_MMA(0, 0, At, B0); PG8_MMA(0, 1, At, B1); PG8_BAR; PG8_SCHED;
            PG8_LDA(At, 0, 1); PG8_STAGE(PG8_SB(0, 0), b2, voffB); PG8_STAGE(PG8_SB(0, 1), b2 + hstep, voffB); PG8_STAGE(PG8_SA(0, 0), a2, voffA);
            PG8_WAIT_V(8); PG8_WAIT_L(0); PG8_BAR; PG8_MMA(1, 0, At, B0); PG8_MMA(1, 1, At, B1); PG8_BAR; PG8_SCHED;
            PG8_LDB(B0, 1, 0); PG8_LDB(B1, 1, 1); PG8_SCHED; PG8_LDA(At, 1, 0); PG8_STAGE(PG8_SA(0, 1), a2 + hstep, voffA);
            PG8_WAIT_V(8); PG8_WAIT_L(0); PG8_BAR; PG8_MMA(0, 0, At, B0); PG8_MMA(0, 1, At, B1); PG8_BAR; PG8_SCHED;
            PG8_LDA(At, 1, 1); PG8_STAGE(PG8_SB(1, 0), b3, voffB); PG8_STAGE(PG8_SB(1, 1), b3 + hstep, voffB); PG8_STAGE(PG8_SA(1, 0), a3, voffA);
            PG8_WAIT_V(8); PG8_WAIT_L(0); PG8_BAR; PG8_MMA(1, 0, At, B0); PG8_MMA(1, 1, At, B1); PG8_BAR; PG8_SCHED;
            } else {
            PG8_LDB(B0, 0, 0); PG8_SCHED; PG8_LDA(At, 0, 0); PG8_STAGE(PG8_SA(1, 1), a1 + hstep, voffA);
            PG8_WAIT_L(8); PG8_BAR; PG8_WAIT_L(0); PG8_MMA(0, 0, At, B0); PG8_BAR; PG8_SCHED;
            PG8_LDB(B1, 0, 1); PG8_STAGE(PG8_SB(0, 0), b2, voffB);
            PG8_BAR; PG8_WAIT_L(0); PG8_MMA(0, 1, At, B1); PG8_BAR;
            PG8_LDA(At, 0, 1); PG8_STAGE(PG8_SA(0, 0), a2, voffA);
            PG8_BAR; PG8_WAIT_L(0); PG8_MMA(1, 0, At, B0); PG8_BAR; PG8_SCHED;
            PG8_STAGE(PG8_SB(0, 1), b2 + hstep, voffB);
            PG8_WAIT_V(6); PG8_BAR; PG8_MMA(1, 1, At, B1); PG8_BAR;
            PG8_LDB(B0, 1, 0); PG8_SCHED; PG8_LDA(At, 1, 0); PG8_STAGE(PG8_SA(0, 1), a2 + hstep, voffA);
            PG8_WAIT_L(8); PG8_BAR; PG8_WAIT_L(0); PG8_MMA(0, 0, At, B0); PG8_BAR; PG8_SCHED;
            PG8_LDB(B1, 1, 1); PG8_STAGE(PG8_SB(1, 0), b3, voffB);
            PG8_BAR; PG8_WAIT_L(0); PG8_MMA(0, 1, At, B1); PG8_BAR;
            PG8_LDA(At, 1, 1); PG8_STAGE(PG8_SA(1, 0), a3, voffA);
            PG8_BAR; PG8_WAIT_L(0); PG8_MMA(1, 0, At, B0); PG8_BAR; PG8_SCHED;
            PG8_STAGE(PG8_SB(1, 1), b3 + hstep, voffB);
            PG8_WAIT_V(6); PG8_BAR; PG8_MMA(1, 1, At, B1); PG8_BAR;
            }
        }
        if constexpr (ALIGN_EPI) { if (wr == 0) PG8_BAR; }
        if constexpr (!Epi::AFTER_DRAIN) { E(acc, cur, wr, wc, fr, fq); S.done(cur); }
        if (!has_next) break;
#pragma unroll
        for (int a = 0; a < 2; ++a)
#pragma unroll
            for (int b = 0; b < 2; ++b)
#pragma unroll
                for (int m = 0; m < 4; ++m)
#pragma unroll
                    for (int n = 0; n < 2; ++n) acc[a][b][m][n] = (f32x4){0.f, 0.f, 0.f, 0.f};
        cur = nxt; cA = nA; cB = nB; ++ui;
        if constexpr (ALIGN_EPI) { if (wr == 1) PG8_BAR; }
    }
    PG8_WAIT_V(0);
    if constexpr (!ALIGN_EPI) { if (wr == 0) PG8_BAR; }
    PG8_BAR;
    if constexpr (Epi::AFTER_DRAIN) { E.fused(acc, cur, wr, wc, fr, fq, lds, wid, lane); S.done(cur); }
#undef PG8_SA
#undef PG8_SB
#undef PG8_STAGE
#undef PG8_LDA
#undef PG8_LDB
#undef PG8_MMA
#undef PG8_WAIT_V
#undef PG8_WAIT_L
#undef PG8_BAR
#undef PG8_SCHED
}
}


#define GAS __attribute__((address_space(1)))
#define LAS __attribute__((address_space(3)))
typedef unsigned short bf16_t;
typedef float f32x4 __attribute__((ext_vector_type(4)));
typedef short s16x4 __attribute__((ext_vector_type(4)));
typedef short s16x8 __attribute__((ext_vector_type(8)));
typedef unsigned u32x4 __attribute__((ext_vector_type(4)));
typedef unsigned u32x2 __attribute__((ext_vector_type(2)));

constexpr int NWAVES = 8, NTHR = 512;
constexpr int DM = 2048, DEPTH = 4, HROWS = 32768, INW = 6144, DFF = 5632, LRUW = 1024;
constexpr float EPS = 1e-6f;
constexpr int NPH = 10;

constexpr size_t MiB = 1u << 20;
constexpr size_t WS_CTL = 0, CTL_ZERO_BYTES = 64 * 1024;
constexpr size_t WS_RSTAT = 1 * MiB;
constexpr size_t WS_COS = 2 * MiB, WS_SIN = 4 * MiB;
constexpr size_t WS_AGG = 6 * MiB;
constexpr size_t WS_CARRY = 10 * MiB;
constexpr size_t WS_WIN = 16 * MiB;
constexpr size_t WS_WOUT = 40 * MiB;
constexpr size_t WS_WGU = 48 * MiB;
constexpr size_t WS_WDN = 92 * MiB;
constexpr size_t WS_WLRU = 114 * MiB;
constexpr size_t WS_XB = 116 * MiB;
constexpr size_t WS_BIG = 372 * MiB;
constexpr size_t WS_ST = 756 * MiB;
constexpr size_t WS_LRU = 884 * MiB;
constexpr size_t WS_END = 1076 * MiB;
constexpr int LDS_WORK = 139264, LDS_BYTES = LDS_WORK + 1024 + 4096;

#define LDS_WAIT() asm volatile("s_waitcnt lgkmcnt(0)" ::: "memory")

__device__ __forceinline__ unsigned pk2(float lo, float hi) { return pg8::cvt_pk_bf16(lo, hi); }
__device__ __forceinline__ float bflo(unsigned w) { return __uint_as_float(w << 16); }
__device__ __forceinline__ float bfhi(unsigned w) { return __uint_as_float(w & 0xffff0000u); }
__device__ __forceinline__ float wave_sum(float v) {
#pragma unroll
    for (int o = 1; o < 64; o <<= 1) v += __shfl_xor(v, o);
    return v;
}
__device__ __forceinline__ float fexp2(float x) { return __builtin_amdgcn_exp2f(x); }
__device__ __forceinline__ float fsigmoid(float x) { return __builtin_amdgcn_rcpf(1.0f + fexp2(-1.44269504089f * x)); }

__device__ __forceinline__ unsigned off_b(unsigned row, unsigned ch) { return 256u * row + 16u * (ch ^ (((row & 3u) << 2) | ((row >> 2) & 3u))); }
__device__ __forceinline__ s16x8 row_frag(LAS unsigned char* img, int rb, int ks, int lane) { return *(LAS s16x8*)(img + off_b((unsigned)((lane & 15) + 16 * rb), (unsigned)(4 * ks + (lane >> 4)))); }
__device__ __forceinline__ s16x8 tr_frag(LAS unsigned char* img, int c, int ks, int lane) {
    const unsigned g = (unsigned)lane >> 4, q = ((unsigned)lane & 15u) >> 2, p = (unsigned)lane & 3u, row = 32u * ks + 8u * g + q, ch = 2u * c + (p >> 1);
    const s16x4 lo = __builtin_amdgcn_ds_read_tr16_b64_v4i16((LAS s16x4*)(img + off_b(row, ch) + 8u * (p & 1u)));
    const s16x4 hi = __builtin_amdgcn_ds_read_tr16_b64_v4i16((LAS s16x4*)(img + off_b(row + 4u, ch) + 8u * (p & 1u)));
    return __builtin_shufflevector(lo, hi, 0, 1, 2, 3, 4, 5, 6, 7);
}
#define MFMA16(a, b, c) __builtin_amdgcn_mfma_f32_16x16x32_bf16((a), (b), (c), 0, 0, 0)

#define XB_TMO      128
#define XB_XCNT(j)  (256  + 64 * (j))
#define XB_XSUB(j)  (1280 + 64 * (j))
#define XB_XGEN(j)  (2304 + 64 * (j))
#define XB_TOP      3328
#define XB_TOPGEN   3392
#define XCD_BAR_WORDS 3456
#define XB_SPIN_CAP (1u << 18)

__device__ __forceinline__ unsigned xb_ld(unsigned* p)              { return __hip_atomic_load(p, __ATOMIC_RELAXED, __HIP_MEMORY_SCOPE_AGENT); }
__device__ __forceinline__ unsigned xb_add(unsigned* p, unsigned v) { return __hip_atomic_fetch_add(p, v, __ATOMIC_RELAXED, __HIP_MEMORY_SCOPE_AGENT); }
__device__ __forceinline__ unsigned xb_xcc_id() { return (unsigned)__builtin_amdgcn_s_getreg((3 << 11) | 20) & 0xFu; }
#define XB_SPIN(cond, bar) do { unsigned _sp = 0; while (cond) { __builtin_amdgcn_s_sleep(1); \
    if ((++_sp & 255u) == 0u) { if (xb_ld(&(bar)[XB_TMO])) break; if (_sp > XB_SPIN_CAP) { atomicAdd(&(bar)[XB_TMO], 1u); break; } } } } while (0)

struct XcdBarrier {
    unsigned* bar; unsigned x;
    volatile LAS unsigned* st;
};

__device__ __forceinline__ XcdBarrier xcd_barrier_post(unsigned* bar, volatile LAS unsigned* st) {
    XcdBarrier b; b.bar = bar; b.x = xb_xcc_id(); b.st = st;
    if (threadIdx.x == 0) (void)xb_add(&bar[XB_XCNT(b.x)], 1u);
    return b;
}
__device__ __forceinline__ void xcd_barrier_complete(unsigned* bar, unsigned x, unsigned& nloc, unsigned& nx) {
    const unsigned G = gridDim.x * gridDim.y * gridDim.z;
    unsigned sum, cnt, mine, sp = 0u;
    for (;;) {
        sum = 0u; cnt = 0u; mine = 0u;
#pragma unroll
        for (unsigned j = 0; j < 16; ++j) { const unsigned c = xb_ld(&bar[XB_XCNT(j)]); sum += c; cnt += (c > 0u) ? 1u : 0u; mine = (j == x) ? c : mine; }
        if (sum == G) break;
        __builtin_amdgcn_s_sleep(1);
        if ((++sp & 255u) == 0u) { if (xb_ld(&bar[XB_TMO])) break; if (sp > XB_SPIN_CAP) { atomicAdd(&bar[XB_TMO], 1u); break; } }
    }
    nloc = mine > 0u ? mine : 1u; nx = cnt > 0u ? cnt : 1u;
}

__device__ __forceinline__ void xcd_barrier(const XcdBarrier& b) {
    asm volatile("s_waitcnt vmcnt(0)" ::: "memory");
    __syncthreads();
    if (threadIdx.x == 0) {
        unsigned* bar = b.bar;
        __builtin_amdgcn_s_waitcnt(0);
        unsigned nloc = b.st[0], nx = b.st[1];
        if (nloc == 0u) { xcd_barrier_complete(bar, b.x, nloc, nx); b.st[0] = nloc; b.st[1] = nx; }
        const unsigned old = xb_add(&bar[XB_XSUB(b.x)], 1u);
        const unsigned gen = old / nloc;
        if (old + 1u == (gen + 1u) * nloc) {
            __builtin_amdgcn_fence(__ATOMIC_RELEASE, "agent");
            asm volatile("s_waitcnt vmcnt(0)" ::: "memory");
            const unsigned og = xb_add(&bar[XB_TOP], 1u);
            const unsigned tg = og / nx;
            if (og + 1u == (tg + 1u) * nx) xb_add(&bar[XB_TOPGEN], 1u);
            else XB_SPIN(xb_ld(&bar[XB_TOPGEN]) == tg, bar);
            __builtin_amdgcn_fence(__ATOMIC_ACQUIRE, "agent");
            xb_add(&bar[XB_XGEN(b.x)], 1u);
            asm volatile("s_waitcnt vmcnt(0)" ::: "memory");
        } else {
            XB_SPIN(xb_ld(&bar[XB_XGEN(b.x)]) == gen, bar);
            __builtin_amdgcn_fence(__ATOMIC_ACQUIRE, "agent");
            asm volatile("s_waitcnt vmcnt(0)" ::: "memory");
        }
    }
    __syncthreads();
}
struct Args { const float* in[25]; float* out; unsigned char* ws; int l_lo, l_hi, h_lo, h_hi, p_lo, p_hi, use_bar, pad; };

__device__ __forceinline__ void cvt_tile(const float* colp, int ldw, const float* gain, float nsc, int k0, bf16_t* dst, int K, LAS float* scr, int lane) {
#pragma unroll
    for (int i = 0; i < 32; ++i) { const int kk = 2 * i + (lane >> 5); const float g = gain ? gain[k0 + kk] * nsc : nsc; scr[kk * 33 + (lane & 31)] = colp[(size_t)(k0 + kk) * ldw] * g; }
    LDS_WAIT(); asm volatile("" ::: "memory");
    const int c = lane & 7;
#pragma unroll
    for (int j = 0; j < 4; ++j) { const int n = (lane >> 3) + 8 * j; const LAS float* s = scr + (8 * c) * 33 + n;
        u32x4 o; o.x = pk2(s[0 * 33], s[1 * 33]); o.y = pk2(s[2 * 33], s[3 * 33]); o.z = pk2(s[4 * 33], s[5 * 33]); o.w = pk2(s[6 * 33], s[7 * 33]);
        *(u32x4*)(dst + (size_t)n * K + 8 * c) = o; }
    LDS_WAIT(); asm volatile("" ::: "memory");
}
__device__ __forceinline__ void phase_convert(const Args& A, int l, LAS unsigned char* lds, int tid, int lane, int wave, int it_lo, int it_hi, int prologue) {
    unsigned char* ws = A.ws;
    LAS float* scr = (LAS float*)(lds + wave * 16384);
    const int gw = blockIdx.x * NWAVES + wave, NGW = gridDim.x * NWAVES;
    constexpr int I_WIN = 32 * 192, I_WOUT = 32 * 64, I_WGU = 32 * 352, I_WDN = 88 * 64, I_LRU = 256;
    constexpr int NITEMS = I_WIN + I_WOUT + I_WGU + I_WDN + I_LRU;
    static_assert(NITEMS == 25344, "item list");
    for (int it = it_lo + gw; it < it_hi; it += NGW) {
        int r = it;
        if (r < I_WIN) { const int kb = r / 192, nb = r % 192, n = 32 * nb + (lane & 31); int src = n; float nsc = 1.f;
            if (n < 2048) { const int sec = n >> 10, w = n & 1023, head = w >> 7, p = w & 127; src = sec * 1024 + head * 128 + 64 * ((p >> 2) & 1) + 16 * (p >> 5) + 4 * ((p >> 3) & 3) + (p & 3); nsc = sec ? 0.08838834764831845f : 1.f; }
            cvt_tile(A.in[3] + (size_t)l * 2048 * 6144 + src, 6144, A.in[2] + l * 2048, nsc, 64 * kb, (bf16_t*)(ws + WS_WIN) + (size_t)(32 * nb) * 2048 + 64 * kb, 2048, scr, lane); continue; }
        r -= I_WIN;
        if (r < I_WOUT) { const int kb = r / 64, nb = r % 64, n = 32 * nb + (lane & 31);
            cvt_tile(A.in[18] + (size_t)l * 2048 * 2048 + n, 2048, nullptr, 1.f, 64 * kb, (bf16_t*)(ws + WS_WOUT) + (size_t)(32 * nb) * 2048 + 64 * kb, 2048, scr, lane); continue; }
        r -= I_WOUT;
        if (r < I_WGU) { const int kb = r / 352, nb = r % 352, n = 32 * nb + (lane & 31); const int pn = n >> 8, bj = (n >> 7) & 1, c = n & 127;
            const float* W = (bj ? A.in[22] : A.in[21]) + (size_t)l * 2048 * 5632 + 128 * pn + c;
            cvt_tile(W, 5632, A.in[20] + l * 2048, 1.f, 64 * kb, (bf16_t*)(ws + WS_WGU) + (size_t)(32 * nb) * 2048 + 64 * kb, 2048, scr, lane); continue; }
        r -= I_WGU;
        if (r < I_WDN) { const int kb = r / 64, nb = r % 64, n = 32 * nb + (lane & 31);
            cvt_tile(A.in[23] + (size_t)l * 5632 * 2048 + n, 2048, nullptr, 1.f, 64 * kb, (bf16_t*)(ws + WS_WDN) + (size_t)(32 * nb) * 5632 + 64 * kb, 5632, scr, lane); continue; }
        r -= I_WDN;
        { const int mat = r >> 3, g = mat >> 2, gate = mat & 3, sub = r & 7, kb = sub >> 2, nb = sub & 3, n = 32 * nb + (lane & 31);
            const float* W = (gate == 0 ? A.in[7] : gate == 1 ? A.in[9] : gate == 2 ? A.in[12] : A.in[14]) + (size_t)(l * 8 + g) * 128 * 128 + n;
            cvt_tile(W, 128, nullptr, 1.f, 64 * kb, (bf16_t*)(ws + WS_WLRU) + (size_t)(mat * 128 + 32 * nb) * 128 + 64 * kb, 128, scr, lane); }
    }
    if (prologue & 1) {
        float* cosT = (float*)(ws + WS_COS); float* sinT = (float*)(ws + WS_SIN);
        for (int i = blockIdx.x * NTHR + tid; i < 8192 * 64; i += gridDim.x * NTHR) { const int pos = i >> 6, j = i & 63;
            const float inv = __builtin_amdgcn_exp2f(-(float)j * 0.20762050593046014f); const float ang = (float)pos * inv;
            const double rev = (double)ang * 0.15915494309189535; const float fr = (float)(rev - floor(rev));
            cosT[i] = __builtin_amdgcn_cosf(fr); sinT[i] = __builtin_amdgcn_sinf(fr); }
    }
    if (prologue & 6) {
        float* rstat = (float*)(ws + WS_RSTAT); bf16_t* xb = (bf16_t*)(ws + WS_XB);
        const int m_lo = (prologue & 2) ? 0 : HROWS, m_hi = (prologue & 4) ? 2 * HROWS : HROWS;
        for (int m = m_lo + gw; m < m_hi; m += NGW) {
            const float* xr = (m < HROWS ? A.in[0] + (size_t)m * DM : A.in[1] + (size_t)(m - HROWS) * DM);
            f32x4 v[8]; float ss = 0.f;
#pragma unroll
            for (int j = 0; j < 8; ++j) { v[j] = ((const f32x4*)xr)[lane + 64 * j]; ss += (v[j][0] * v[j][0] + v[j][1] * v[j][1]) + (v[j][2] * v[j][2] + v[j][3] * v[j][3]); }
            ss = wave_sum(ss);
            u32x2* o = (u32x2*)(xb + (size_t)m * DM);
#pragma unroll
            for (int j = 0; j < 8; ++j) { u32x2 w; w.x = pk2(v[j][0], v[j][1]); w.y = pk2(v[j][2], v[j][3]); o[lane + 64 * j] = w; }
            if (lane == 0) rstat[m] = 1.0f / sqrtf(ss * (1.0f / DM) + EPS);
        }
    }
}

__device__ __forceinline__ void phase_residual(bf16_t* xb, const bf16_t* br, const float* gain, float* rstat, float* xf32, int lane, int wave) {
    const int gw = blockIdx.x * NWAVES + wave, NGW = gridDim.x * NWAVES;
    f32x4 g[8];
#pragma unroll
    for (int j = 0; j < 4; ++j) { g[2 * j] = ((const f32x4*)gain)[2 * (lane + 64 * j)]; g[2 * j + 1] = ((const f32x4*)gain)[2 * (lane + 64 * j) + 1]; }
    u32x4 bn[4], xn[4];
    if (gw < HROWS) {
#pragma unroll
        for (int j = 0; j < 4; ++j) { bn[j] = ((const u32x4*)(br + (size_t)gw * DM))[lane + 64 * j]; xn[j] = ((const u32x4*)(xb + (size_t)gw * DM))[lane + 64 * j]; } }
#pragma unroll 1
    for (int m = gw; m < HROWS; m += NGW) {
        u32x4* xp = (u32x4*)(xb + (size_t)m * DM);
        u32x4 b[4], xv[4]; float ss = 0.f;
#pragma unroll
        for (int j = 0; j < 4; ++j) { b[j] = bn[j]; xv[j] = xn[j]; }
        if (m + NGW < HROWS) {
#pragma unroll
            for (int j = 0; j < 4; ++j) { bn[j] = ((const u32x4*)(br + (size_t)(m + NGW) * DM))[lane + 64 * j]; xn[j] = ((const u32x4*)(xb + (size_t)(m + NGW) * DM))[lane + 64 * j]; } }
        f32x4 f[8], x[8];
#pragma unroll
        for (int j = 0; j < 4; ++j) { f[2 * j] = (f32x4){bflo(b[j].x), bfhi(b[j].x), bflo(b[j].y), bfhi(b[j].y)}; f[2 * j + 1] = (f32x4){bflo(b[j].z), bfhi(b[j].z), bflo(b[j].w), bfhi(b[j].w)};
            x[2 * j] = (f32x4){bflo(xv[j].x), bfhi(xv[j].x), bflo(xv[j].y), bfhi(xv[j].y)}; x[2 * j + 1] = (f32x4){bflo(xv[j].z), bfhi(xv[j].z), bflo(xv[j].w), bfhi(xv[j].w)}; }
#pragma unroll
        for (int j = 0; j < 8; ++j) ss += (f[j][0] * f[j][0] + f[j][1] * f[j][1]) + (f[j][2] * f[j][2] + f[j][3] * f[j][3]);
        const float s = 1.0f / sqrtf(wave_sum(ss) * (1.0f / DM) + EPS);
        float s2 = 0.f;
#pragma unroll
        for (int j = 0; j < 8; ++j) { x[j] = x[j] + f[j] * s * g[j]; s2 += (x[j][0] * x[j][0] + x[j][1] * x[j][1]) + (x[j][2] * x[j][2] + x[j][3] * x[j][3]); }
        if (xf32) { f32x4* op = (f32x4*)(xf32 + (size_t)m * DM);
#pragma unroll
            for (int j = 0; j < 4; ++j) { op[2 * (lane + 64 * j)] = x[2 * j]; op[2 * (lane + 64 * j) + 1] = x[2 * j + 1]; }
        } else {
            s2 = wave_sum(s2);
#pragma unroll
            for (int j = 0; j < 4; ++j) { u32x4 w; w.x = pk2(x[2 * j][0], x[2 * j][1]); w.y = pk2(x[2 * j][2], x[2 * j][3]); w.z = pk2(x[2 * j + 1][0], x[2 * j + 1][1]); w.w = pk2(x[2 * j + 1][2], x[2 * j + 1][3]); xp[lane + 64 * j] = w; }
            if (lane == 0) rstat[m] = 1.0f / sqrtf(s2 * (1.0f / DM) + EPS);
        }
    }
}
__device__ __forceinline__ float head_l2g(int head) { return __builtin_log2f(1.0f - __builtin_exp2f(-5.0f - (float)head)); }

__device__ __forceinline__ void b1_chunk(LAS unsigned char* lds, const bf16_t* proj, bf16_t* st, int ck, int tid_in) {
    LAS unsigned char* imV = lds; LAS unsigned char* imKf = lds + 32768; LAS unsigned char* imKb = lds + 65536;
    u32x4 pf[8];
    {   int tid = tid_in; asm volatile("" : "+v"(tid)); const bf16_t* Kg = proj + (size_t)(ck * 128) * INW + 1024;
#pragma unroll
        for (int i = 0; i < 4; ++i) { const int q = tid + 512 * i, row = q >> 4, ch = q & 15; pf[i] = *(const u32x4*)(Kg + (size_t)row * INW + ch * 8); pf[4 + i] = *(const u32x4*)(Kg + 1024 + (size_t)row * INW + ch * 8); } }
#pragma unroll 1
    for (int head = 0; head < 8; ++head) {
        int tid = tid_in; asm volatile("" : "+v"(tid)); const int lane = tid & 63, wid = __builtin_amdgcn_readfirstlane(tid >> 6);
        const float l2g = head_l2g(head);
        __syncthreads();
#pragma unroll
        for (int i = 0; i < 4; ++i) { const int q = tid + 512 * i, row = q >> 4, ch = q & 15; const u32x4 kv = pf[i];
            const float sf = fexp2(l2g * (float)(127 - row)), sb = fexp2(l2g * (float)row); const unsigned off = off_b(row, ch);
            *(LAS u32x4*)(imV + off) = pf[4 + i];
            u32x4 kf, kb;
            kf.x = pk2(bflo(kv.x) * sf, bfhi(kv.x) * sf); kf.y = pk2(bflo(kv.y) * sf, bfhi(kv.y) * sf); kf.z = pk2(bflo(kv.z) * sf, bfhi(kv.z) * sf); kf.w = pk2(bflo(kv.w) * sf, bfhi(kv.w) * sf);
            kb.x = pk2(bflo(kv.x) * sb, bfhi(kv.x) * sb); kb.y = pk2(bflo(kv.y) * sb, bfhi(kv.y) * sb); kb.z = pk2(bflo(kv.z) * sb, bfhi(kv.z) * sb); kb.w = pk2(bflo(kv.w) * sb, bfhi(kv.w) * sb);
            *(LAS u32x4*)(imKf + off) = kf; *(LAS u32x4*)(imKb + off) = kb; }
        __syncthreads();
        if (head < 7) { const bf16_t* Kg = proj + (size_t)(ck * 128) * INW + 1024 + (head + 1) * 128;
#pragma unroll
            for (int i = 0; i < 4; ++i) { const int q = tid + 512 * i, row = q >> 4, ch = q & 15; pf[i] = *(const u32x4*)(Kg + (size_t)row * INW + ch * 8); pf[4 + i] = *(const u32x4*)(Kg + 1024 + (size_t)row * INW + ch * 8); } }
        const int wr = wid >> 2, wc = wid & 3, fr = lane & 15, fq = lane >> 4;
        f32x4 accf[4][2], accb[4][2];
#pragma unroll
        for (int a = 0; a < 4; ++a)
#pragma unroll
            for (int b = 0; b < 2; ++b) { accf[a][b] = (f32x4){0.f, 0.f, 0.f, 0.f}; accb[a][b] = (f32x4){0.f, 0.f, 0.f, 0.f}; }
#pragma unroll
        for (int ks = 0; ks < 4; ++ks) {
            s16x8 Y[2], Xf[4], Xb[4];
#pragma unroll
            for (int nt = 0; nt < 2; ++nt) Y[nt] = tr_frag(imV, 2 * wc + nt, ks, lane);
#pragma unroll
            for (int mt = 0; mt < 4; ++mt) { Xf[mt] = tr_frag(imKf, 4 * wr + mt, ks, lane); Xb[mt] = tr_frag(imKb, 4 * wr + mt, ks, lane); }
#pragma unroll
            for (int mt = 0; mt < 4; ++mt)
#pragma unroll
                for (int nt = 0; nt < 2; ++nt) { accf[mt][nt] = MFMA16(Xf[mt], Y[nt], accf[mt][nt]); accb[mt][nt] = MFMA16(Xb[mt], Y[nt], accb[mt][nt]); }
        }
        bf16_t* stf = st + ((size_t)(ck * 8 + head) * 2) * 16384; bf16_t* stb = stf + 16384;
#pragma unroll
        for (int mt = 0; mt < 4; ++mt)
#pragma unroll
            for (int nt = 0; nt < 2; ++nt) { const int d = 64 * wr + 16 * mt + 4 * fq, e = 32 * wc + 16 * nt + fr;
                u32x2 w; w.x = pk2(accf[mt][nt][0], accf[mt][nt][1]); w.y = pk2(accf[mt][nt][2], accf[mt][nt][3]); *(u32x2*)(stf + e * 128 + d) = w;
                w.x = pk2(accb[mt][nt][0], accb[mt][nt][1]); w.y = pk2(accb[mt][nt][2], accb[mt][nt][3]); *(u32x2*)(stb + e * 128 + d) = w; }
    }
    __syncthreads();
}

struct LruP { const float* conv_w; const float* conv_b; const float* ba[2]; const float* bx[2]; const float* lam[2]; };
__device__ __forceinline__ void l1_unit(LAS unsigned char* lds, const bf16_t* proj, const bf16_t* Wl, bf16_t* lbuf, float* agg, const LruP& P, int ck, int smask, int tid_in) {
    const int r0 = ck * 128, pos0 = r0 & smask, S = smask + 1;
    u32x4 un[7];
    {   int tid = tid_in; asm volatile("" : "+v"(tid)); const int ch = tid & 15, tg = tid >> 4;
#pragma unroll
        for (int j = 0; j < 7; ++j) { const int t = 4 * tg - 2 + j, pos = pos0 + t; un[j] = (u32x4){0u, 0u, 0u, 0u};
            if (pos >= 0 && pos < S) un[j] = *(const u32x4*)(proj + (size_t)(r0 + t) * INW + 4096 + ch * 8); } }
#pragma unroll 1
    for (int g = 0; g < 8; ++g) {
        int tid = tid_in; asm volatile("" : "+v"(tid)); int lane = tid & 63, fr = lane & 15, fq = lane >> 4; const int wid = __builtin_amdgcn_readfirstlane(tid >> 6);
        LAS unsigned char* imU = lds + (g & 1) * 32768; LAS unsigned char* sY = lds + 65536 + wid * 8448; LAS unsigned char* sF = sY + 4224; LAS unsigned char* sB = sF + 2112;
        const int cb = 16 * wid + fr, c = g * 128 + cb;
        s16x8 Bw[2][4];
#pragma unroll
        for (int gt = 0; gt < 2; ++gt)
#pragma unroll
            for (int ks = 0; ks < 4; ++ks) Bw[gt][ks] = *(const s16x8*)(Wl + ((size_t)((g * 4 + gt) * 128 + cb)) * 128 + 32 * ks + 8 * fq);
        {   const int ch = tid & 15, tg = tid >> 4, c0 = g * 128 + ch * 8; u32x4 u[7];
#pragma unroll
            for (int j = 0; j < 7; ++j) u[j] = un[j];
            const f32x4 b0 = *(const f32x4*)(P.conv_b + c0), b1 = *(const f32x4*)(P.conv_b + c0 + 4);
            f32x4 a0[4], a1[4];
#pragma unroll
            for (int o = 0; o < 4; ++o) { a0[o] = b0; a1[o] = b1; }
#pragma unroll
            for (int k = 0; k < 4; ++k) { const f32x4 w0 = *(const f32x4*)(P.conv_w + k * 1024 + c0), w1 = *(const f32x4*)(P.conv_w + k * 1024 + c0 + 4);
#pragma unroll
                for (int o = 0; o < 4; ++o) { const u32x4 v = u[o + k];
                    a0[o] += (f32x4){bflo(v.x), bfhi(v.x), bflo(v.y), bfhi(v.y)} * w0; a1[o] += (f32x4){bflo(v.z), bfhi(v.z), bflo(v.w), bfhi(v.w)} * w1; } }
#pragma unroll
            for (int o = 0; o < 4; ++o) { u32x4 w; w.x = pk2(a0[o][0], a0[o][1]); w.y = pk2(a0[o][2], a0[o][3]); w.z = pk2(a1[o][0], a1[o][1]); w.w = pk2(a1[o][2], a1[o][3]);
                *(LAS u32x4*)(imU + off_b((unsigned)(4 * tg + o), (unsigned)ch)) = w; } }
        __syncthreads();
        if (g < 7) { const int ch = tid & 15, tg = tid >> 4;
#pragma unroll
            for (int j = 0; j < 7; ++j) { const int t = 4 * tg - 2 + j, pos = pos0 + t; un[j] = (u32x4){0u, 0u, 0u, 0u};
                if (pos >= 0 && pos < S) un[j] = *(const u32x4*)(proj + (size_t)(r0 + t) * INW + 4096 + (g + 1) * 128 + ch * 8); } }
#pragma unroll
        for (int dir = 0; dir < 2; ++dir) {
            { int t2 = tid; asm volatile("" : "+v"(t2)); lane = t2 & 63; fr = lane & 15; fq = lane >> 4; }
            f32x4 acc[8][2];
#pragma unroll
            for (int m = 0; m < 8; ++m) { acc[m][0] = (f32x4){0.f, 0.f, 0.f, 0.f}; acc[m][1] = (f32x4){0.f, 0.f, 0.f, 0.f}; }
#pragma unroll
            for (int ks = 0; ks < 4; ++ks) {
#pragma unroll
                for (int m = 0; m < 8; ++m) { const s16x8 Af = *(LAS s16x8*)(imU + off_b((unsigned)(32 * (fr >> 2) + 4 * m + (fr & 3)), (unsigned)(4 * ks + fq)));
                    acc[m][0] = MFMA16(Af, Bw[0][ks], acc[m][0]); acc[m][1] = MFMA16(Af, Bw[1][ks], acc[m][1]); } }
            if (dir == 0) {
#pragma unroll
                for (int gt = 0; gt < 2; ++gt)
#pragma unroll
                    for (int ks = 0; ks < 4; ++ks) Bw[gt][ks] = *(const s16x8*)(Wl + ((size_t)((g * 4 + 2 + gt) * 128 + cb)) * 128 + 32 * ks + 8 * fq); }
            const float nba = -1.44269504089f * P.ba[dir][c], nbx = -1.44269504089f * P.bx[dir][c], lam = P.lam[dir][c];
            const float c8sp = -8.0f * 1.44269504089f * log1pf(expf(-lam));
            float Pseg = 1.f, Eseg = 0.f;
#pragma unroll
            for (int mm = 0; mm < 8; ++mm) { const int m = dir ? 7 - mm : mm;
                const unsigned q = ((unsigned)lane & 15u) >> 2, p = (unsigned)lane & 3u;
                const s16x4 t = __builtin_amdgcn_ds_read_tr16_b64_v4i16((LAS s16x4*)(imU + off_b(32u * fq + 4u * m + q, 2u * wid + (p >> 1)) + 8u * (p & 1u)));
#pragma unroll
                for (int rr = 0; rr < 4; ++rr) { const int r = dir ? 3 - rr : rr;
                    const float ucv = __uint_as_float(((unsigned)(unsigned short)t[r]) << 16);
                    const float rg = __builtin_amdgcn_rcpf(1.0f + fexp2(fmaf(acc[m][0][r], -1.44269504089f, nba))), ig = __builtin_amdgcn_rcpf(1.0f + fexp2(fmaf(acc[m][1][r], -1.44269504089f, nbx)));
                    const float a = fexp2(c8sp * rg), b = __builtin_amdgcn_sqrtf(fmaxf(fmaf(-a, a, 1.0f), 0.0f)) * (ig * ucv);
                    acc[m][0][r] = a; acc[m][1][r] = b; Eseg = fmaf(a, Eseg, b); Pseg *= a; } }
            float Ps[4], Es[4];
#pragma unroll
            for (int s = 0; s < 4; ++s) { Ps[s] = __shfl(Pseg, fr + 16 * s); Es[s] = __shfl(Eseg, fr + 16 * s); }
            float Apre = 1.f, hpre = 0.f, Pall = 1.f, Eall = 0.f;
#pragma unroll
            for (int ss = 0; ss < 4; ++ss) { const int s = dir ? 3 - ss : ss;
                const bool before = dir ? (s > fq) : (s < fq);
                if (before) { hpre = fmaf(hpre, Ps[s], Es[s]); Apre *= Ps[s]; }
                Eall = fmaf(Eall, Ps[s], Es[s]); Pall *= Ps[s]; }
            if (fq == 0) { agg[((size_t)(ck * 2 + dir) * 2 + 0) * 1024 + c] = Pall; agg[((size_t)(ck * 2 + dir) * 2 + 1) * 1024 + c] = Eall; }
            LAS unsigned char* sA = (dir ? sB : sF) + fq * 528 + fr;
            LAS unsigned char* sy = sY + fq * 1056 + fr * 2;
            float Acum = Apre, h = hpre;
#pragma unroll
            for (int mm = 0; mm < 8; ++mm) { const int m = dir ? 7 - mm : mm;
#pragma unroll
                for (int rr = 0; rr < 4; ++rr) { const int r = dir ? 3 - rr : rr; const int kk = 4 * m + r;
                    Acum *= acc[m][0][r]; h = fmaf(acc[m][0][r], h, acc[m][1][r]);
                    *(LAS unsigned char*)(sA + kk * 16) = (unsigned char)(unsigned)(Acum * 255.0f + 0.5f);
                    float yv = h;
                    if (dir == 1) yv += __uint_as_float(((unsigned)*(LAS unsigned short*)(sy + kk * 32)) << 16);
                    *(LAS unsigned short*)(sy + kk * 32) = (unsigned short)(pk2(yv, 0.f) & 0xffffu); } }
        }
        asm volatile("s_waitcnt lgkmcnt(0)" ::: "memory");
        {
            const int p = lane & 3; unsigned char* l8 = (unsigned char*)lbuf;
#pragma unroll
            for (int it = 0; it < 8; ++it) { const int tok = 16 * it + (lane >> 2), fb = tok >> 5, kk = tok & 31;
                const unsigned so = p < 2 ? (unsigned)(fb * 1056 + kk * 32 + 16 * p) : (unsigned)((p == 2 ? 4224 : 6336) + fb * 528 + kk * 16);
                *(u32x4*)(l8 + (((size_t)(r0 + tok) * 64 + (g * 8 + wid)) * 64 + 16 * p)) = *(LAS u32x4*)(sY + so); } }
        asm volatile("" ::: "memory");
    }
    __syncthreads();
}

__device__ __forceinline__ void b2_item(bf16_t* st, int b, int head, int dir, int slice, int Nc, int tid) {
    const float gC = fexp2(head_l2g(head) * 128.0f);
    bf16_t* base = st + ((size_t)((b * Nc) * 8 + head) * 2 + dir) * 16384 + slice * 4096 + tid * 8;
    const size_t cstride = (size_t)8 * 2 * 16384;
    float s[8];
#pragma unroll
    for (int j = 0; j < 8; ++j) s[j] = 0.f;
    for (int n0 = 0; n0 < Nc; n0 += 16) {
        u32x4 v[16];
#pragma unroll
        for (int u = 0; u < 16; ++u) { const int n = dir ? Nc - 1 - (n0 + u) : n0 + u; v[u] = *(const u32x4*)(base + (size_t)n * cstride); }
#pragma unroll
        for (int u = 0; u < 16; ++u) { const int n = dir ? Nc - 1 - (n0 + u) : n0 + u;
            u32x4 o; o.x = pk2(s[0], s[1]); o.y = pk2(s[2], s[3]); o.z = pk2(s[4], s[5]); o.w = pk2(s[6], s[7]); *(u32x4*)(base + (size_t)n * cstride) = o;
            s[0] = fmaf(s[0], gC, bflo(v[u].x)); s[1] = fmaf(s[1], gC, bfhi(v[u].x)); s[2] = fmaf(s[2], gC, bflo(v[u].y)); s[3] = fmaf(s[3], gC, bfhi(v[u].y));
            s[4] = fmaf(s[4], gC, bflo(v[u].z)); s[5] = fmaf(s[5], gC, bfhi(v[u].z)); s[6] = fmaf(s[6], gC, bflo(v[u].w)); s[7] = fmaf(s[7], gC, bfhi(v[u].w)); }
    }
}
__device__ __forceinline__ void phase_scans(bf16_t* st, const float* agg, float* carry, int nseq, int Nc, int tid) {
    const int nitems = nseq * 64;
    for (int it = blockIdx.x; it < nitems; it += gridDim.x) { const int slice = it & 3, dir = (it >> 2) & 1, head = (it >> 3) & 7, b = it >> 6; b2_item(st, b, head, dir, slice, Nc, tid); }
    const int nthr = nseq * 2048;
    for (int i = blockIdx.x * NTHR + tid; i < nthr; i += gridDim.x * NTHR) { const int c = i & 1023, dir = (i >> 10) & 1, b = i >> 11; float H = 0.f;
        for (int n0 = 0; n0 < Nc; n0 += 8) { float Pv[8], Ev[8];
#pragma unroll
            for (int u = 0; u < 8; ++u) { const int n = dir ? Nc - 1 - (n0 + u) : n0 + u, ck = b * Nc + n;
                Pv[u] = agg[((size_t)(ck * 2 + dir) * 2 + 0) * 1024 + c]; Ev[u] = agg[((size_t)(ck * 2 + dir) * 2 + 1) * 1024 + c]; }
#pragma unroll
            for (int u = 0; u < 8; ++u) { const int n = dir ? Nc - 1 - (n0 + u) : n0 + u, ck = b * Nc + n;
                carry[(size_t)(ck * 2 + dir) * 1024 + c] = H; H = fmaf(H, Pv[u], Ev[u]); } } }
}
__device__ __forceinline__ void b3_chunk(LAS unsigned char* lds, const bf16_t* proj, const bf16_t* st, bf16_t* mix, const float* rnorm, int ck, int tid_in) {
    LAS unsigned char* imK = lds; LAS unsigned char* imV = lds + 32768; LAS unsigned char* imSf = lds + 65536; LAS unsigned char* imSb = lds + 98304;
    u32x4 pf[16]; s16x8 Yqn[4];
    {   int tid = tid_in; asm volatile("" : "+v"(tid)); const int lane = tid & 63, wid = __builtin_amdgcn_readfirstlane(tid >> 6);
        if (tid < 256) *(LAS f32x4*)(lds + LDS_WORK + 1024 + tid * 16) = *(const f32x4*)(rnorm + tid * 4);
#pragma unroll
        for (int ks = 0; ks < 4; ++ks) Yqn[ks] = *(const s16x8*)(proj + (size_t)(ck * 128 + 16 * wid + (lane & 15)) * INW + 32 * ks + 8 * (lane >> 4));
        const bf16_t* Kg = proj + (size_t)(ck * 128) * INW + 1024; const bf16_t* sg = st + ((size_t)(ck * 8) * 2) * 16384;
#pragma unroll
        for (int i = 0; i < 4; ++i) { const int q = tid + 512 * i, row = q >> 4, ch = q & 15;
            pf[i] = *(const u32x4*)(Kg + (size_t)row * INW + ch * 8); pf[4 + i] = *(const u32x4*)(Kg + 1024 + (size_t)row * INW + ch * 8);
            pf[8 + i] = *(const u32x4*)(sg + row * 128 + ch * 8); pf[12 + i] = *(const u32x4*)(sg + 16384 + row * 128 + ch * 8); } }
#pragma unroll 1
    for (int head = 0; head < 8; ++head) {
        int tid = tid_in; asm volatile("" : "+v"(tid)); const int lane = tid & 63, wid = __builtin_amdgcn_readfirstlane(tid >> 6), fr = lane & 15, fq = lane >> 4;
        const float l2g = head_l2g(head);
        const bf16_t* Qg = proj + (size_t)(ck * 128) * INW + head * 128;
        __syncthreads();
#pragma unroll
        for (int i = 0; i < 4; ++i) { const int q = tid + 512 * i, row = q >> 4, ch = q & 15; const unsigned off = off_b(row, ch);
            *(LAS u32x4*)(imK + off) = pf[i]; *(LAS u32x4*)(imV + off) = pf[4 + i]; *(LAS u32x4*)(imSf + off) = pf[8 + i]; *(LAS u32x4*)(imSb + off) = pf[12 + i]; }
        const int i_tok = 16 * wid + fr;
        s16x8 Yq[4];
#pragma unroll
        for (int ks = 0; ks < 4; ++ks) Yq[ks] = Yqn[ks];
        __syncthreads();
        const bf16_t* Gg = Qg + 3072 + (size_t)i_tok * INW;
        u32x2 gv[8];
#pragma unroll
        for (int et = 0; et < 8; ++et) gv[et] = *(const u32x2*)(Gg + 16 * et + 4 * fq);
        if (head < 7) {
            const bf16_t* Kg = proj + (size_t)(ck * 128) * INW + 1024 + (head + 1) * 128; const bf16_t* sg = st + ((size_t)(ck * 8 + head + 1) * 2) * 16384;
#pragma unroll
            for (int ks = 0; ks < 4; ++ks) Yqn[ks] = *(const s16x8*)(Qg + 128 + (size_t)i_tok * INW + 32 * ks + 8 * fq);
#pragma unroll
            for (int i = 0; i < 4; ++i) { const int q = tid + 512 * i, row = q >> 4, ch = q & 15;
                pf[i] = *(const u32x4*)(Kg + (size_t)row * INW + ch * 8); pf[4 + i] = *(const u32x4*)(Kg + 1024 + (size_t)row * INW + ch * 8);
                pf[8 + i] = *(const u32x4*)(sg + row * 128 + ch * 8); pf[12 + i] = *(const u32x4*)(sg + 16384 + row * 128 + ch * 8); } }
        s16x8 Yp[4];
        {   f32x4 accP[8];
#pragma unroll
            for (int jt = 0; jt < 8; ++jt) accP[jt] = (f32x4){0.f, 0.f, 0.f, 0.f};
#pragma unroll
            for (int ks = 0; ks < 4; ++ks)
#pragma unroll
                for (int jt = 0; jt < 8; ++jt) { const unsigned j = 32u * (jt >> 1) + 8u * ((unsigned)fr >> 2) + 4u * (jt & 1) + ((unsigned)fr & 3u);
                    accP[jt] = MFMA16(*(LAS s16x8*)(imK + off_b(j, (unsigned)(4 * ks + fq))), Yq[ks], accP[jt]); }
#pragma unroll
            for (int ks = 0; ks < 4; ++ks) { float w[8];
#pragma unroll
                for (int t = 0; t < 2; ++t)
#pragma unroll
                    for (int r = 0; r < 4; ++r) { const int j = 32 * ks + 8 * fq + 4 * t + r, dd = i_tok - j; w[4 * t + r] = accP[2 * ks + t][r] * fexp2(l2g * (float)(dd < 0 ? -dd : dd)); }
                u32x4 o; o.x = pk2(w[0], w[1]); o.y = pk2(w[2], w[3]); o.z = pk2(w[4], w[5]); o.w = pk2(w[6], w[7]);
                Yp[ks] = __builtin_bit_cast(s16x8, o); }
        }
        f32x4 accI[8], accF[8];
#pragma unroll
        for (int et = 0; et < 8; ++et) { accI[et] = (f32x4){0.f, 0.f, 0.f, 0.f}; accF[et] = (f32x4){0.f, 0.f, 0.f, 0.f}; }
#pragma unroll
        for (int ks = 0; ks < 4; ++ks)
#pragma unroll
            for (int et = 0; et < 8; ++et) { accI[et] = MFMA16(tr_frag(imV, et, ks, lane), Yp[ks], accI[et]); accF[et] = MFMA16(row_frag(imSf, et, ks, lane), Yq[ks], accF[et]); }
        const float qf = fexp2(l2g * (float)(i_tok + 1)), qb = fexp2(l2g * (float)(128 - i_tok));
#pragma unroll
        for (int et = 0; et < 8; ++et) { accI[et] = accI[et] + accF[et] * qf; accF[et] = (f32x4){0.f, 0.f, 0.f, 0.f}; }
#pragma unroll
        for (int ks = 0; ks < 4; ++ks)
#pragma unroll
            for (int et = 0; et < 8; ++et) accF[et] = MFMA16(row_frag(imSb, et, ks, lane), Yq[ks], accF[et]);
        float ss = 0.f;
#pragma unroll
        for (int et = 0; et < 8; ++et) { accI[et] = accI[et] + accF[et] * qb; ss += (accI[et][0] * accI[et][0] + accI[et][1] * accI[et][1]) + (accI[et][2] * accI[et][2] + accI[et][3] * accI[et][3]); }
        ss += __shfl_xor(ss, 16); ss += __shfl_xor(ss, 32);
        const float sc = 1.0f / sqrtf(ss * (1.0f / 128.0f) + EPS);
        bf16_t* op = mix + (size_t)(ck * 128 + i_tok) * DM + head * 128;
#pragma unroll
        for (int et = 0; et < 8; ++et) { const int e = 16 * et + 4 * fq; const f32x4 rn = *(LAS f32x4*)(lds + LDS_WORK + 1024 + (head * 128 + e) * 4);
            const float g0 = bflo(gv[et].x), g1 = bfhi(gv[et].x), g2 = bflo(gv[et].y), g3 = bfhi(gv[et].y);
            u32x2 o; o.x = pk2(accI[et][0] * sc * rn[0] * (g0 * fsigmoid(g0)), accI[et][1] * sc * rn[1] * (g1 * fsigmoid(g1)));
            o.y = pk2(accI[et][2] * sc * rn[2] * (g2 * fsigmoid(g2)), accI[et][3] * sc * rn[3] * (g3 * fsigmoid(g3)));
            *(u32x2*)(op + e) = o; }
    }
    __syncthreads();
}
__device__ __forceinline__ float gelu_tanh(float x) { const float z = 0.7978845608028654f * (x + 0.044715f * x * x * x); const float t = 1.0f - 2.0f * __builtin_amdgcn_rcpf(1.0f + fexp2(2.885390081777927f * z)); return 0.5f * x * (1.0f + t); }
__device__ __forceinline__ void l3_rows(const bf16_t* proj, const bf16_t* lbuf, const float* carry, const float* lnorm, bf16_t* mix, int lane, int wave) {
    const int gw = blockIdx.x * NWAVES + wave, NGW = gridDim.x * NWAVES;
    const unsigned char* l8 = (const unsigned char*)lbuf;
    const int c0 = 16 * lane;
    for (int blk = gw; blk < HROWS / 16; blk += NGW) {
        const int m0 = blk * 16, ck = m0 >> 7;
        f32x4 hf[4], hb[4], ln[4];
#pragma unroll
        for (int q = 0; q < 4; ++q) { hf[q] = *(const f32x4*)(carry + (size_t)(ck * 2 + 0) * 1024 + c0 + 4 * q); hb[q] = *(const f32x4*)(carry + (size_t)(ck * 2 + 1) * 1024 + c0 + 4 * q); ln[q] = *(const f32x4*)(lnorm + c0 + 4 * q); }
        u32x4 rec[4], uy[2];
#pragma unroll
        for (int q = 0; q < 4; ++q) rec[q] = *(const u32x4*)(l8 + ((size_t)m0 * 64 + lane) * 64 + 16 * q);
        uy[0] = *(const u32x4*)(proj + (size_t)m0 * INW + 5120 + c0); uy[1] = *(const u32x4*)(proj + (size_t)m0 * INW + 5120 + c0 + 8);
#pragma unroll 1
        for (int k = 0; k < 16; ++k) { const int m = m0 + k;
            float y[16], gt[16]; float ss = 0.f;
            const float s8 = 1.0f / 255.0f;
#pragma unroll
            for (int q = 0; q < 4; ++q) {
                const unsigned yw0 = q < 2 ? (q == 0 ? rec[0].x : rec[0].z) : (q == 2 ? rec[1].x : rec[1].z), yw1 = q < 2 ? (q == 0 ? rec[0].y : rec[0].w) : (q == 2 ? rec[1].y : rec[1].w);
                const unsigned fw = q == 0 ? rec[2].x : q == 1 ? rec[2].y : q == 2 ? rec[2].z : rec[2].w, bw = q == 0 ? rec[3].x : q == 1 ? rec[3].y : q == 2 ? rec[3].z : rec[3].w;
                y[4 * q + 0] = bflo(yw0) + (float)(fw & 0xffu) * s8 * hf[q][0] + (float)(bw & 0xffu) * s8 * hb[q][0];
                y[4 * q + 1] = bfhi(yw0) + (float)((fw >> 8) & 0xffu) * s8 * hf[q][1] + (float)((bw >> 8) & 0xffu) * s8 * hb[q][1];
                y[4 * q + 2] = bflo(yw1) + (float)((fw >> 16) & 0xffu) * s8 * hf[q][2] + (float)((bw >> 16) & 0xffu) * s8 * hb[q][2];
                y[4 * q + 3] = bfhi(yw1) + (float)(fw >> 24) * s8 * hf[q][3] + (float)(bw >> 24) * s8 * hb[q][3]; }
#pragma unroll
            for (int j = 0; j < 2; ++j) { gt[8 * j + 0] = bflo(uy[j].x); gt[8 * j + 1] = bfhi(uy[j].x); gt[8 * j + 2] = bflo(uy[j].y); gt[8 * j + 3] = bfhi(uy[j].y);
                gt[8 * j + 4] = bflo(uy[j].z); gt[8 * j + 5] = bfhi(uy[j].z); gt[8 * j + 6] = bflo(uy[j].w); gt[8 * j + 7] = bfhi(uy[j].w); }
            if (k < 15) {
#pragma unroll
                for (int q = 0; q < 4; ++q) rec[q] = *(const u32x4*)(l8 + ((size_t)(m + 1) * 64 + lane) * 64 + 16 * q);
                uy[0] = *(const u32x4*)(proj + (size_t)(m + 1) * INW + 5120 + c0); uy[1] = *(const u32x4*)(proj + (size_t)(m + 1) * INW + 5120 + c0 + 8); }
#pragma unroll
            for (int q = 0; q < 16; ++q) ss += y[q] * y[q];
            const float sc = 1.0f / sqrtf(wave_sum(ss) * (1.0f / LRUW) + EPS);
            u32x4 o[2];
#pragma unroll
            for (int j = 0; j < 2; ++j) {
                o[j].x = pk2(y[8 * j + 0] * sc * ln[2 * j][0] * gelu_tanh(gt[8 * j + 0]), y[8 * j + 1] * sc * ln[2 * j][1] * gelu_tanh(gt[8 * j + 1]));
                o[j].y = pk2(y[8 * j + 2] * sc * ln[2 * j][2] * gelu_tanh(gt[8 * j + 2]), y[8 * j + 3] * sc * ln[2 * j][3] * gelu_tanh(gt[8 * j + 3]));
                o[j].z = pk2(y[8 * j + 4] * sc * ln[2 * j + 1][0] * gelu_tanh(gt[8 * j + 4]), y[8 * j + 5] * sc * ln[2 * j + 1][1] * gelu_tanh(gt[8 * j + 5]));
                o[j].w = pk2(y[8 * j + 6] * sc * ln[2 * j + 1][2] * gelu_tanh(gt[8 * j + 6]), y[8 * j + 7] * sc * ln[2 * j + 1][3] * gelu_tanh(gt[8 * j + 7])); }
            *(u32x4*)(mix + (size_t)m * DM + 1024 + c0) = o[0]; *(u32x4*)(mix + (size_t)m * DM + 1024 + c0 + 8) = o[1];
        }
    }
}
#ifndef WGM_NARROW
#define WGM_NARROW 4
#endif
__global__ void __launch_bounds__(NTHR, 2) hymba_fwd(Args A) {
    extern __shared__ __attribute__((aligned(16))) unsigned char lds_raw[];
    LAS unsigned char* lds = (LAS unsigned char*)lds_raw;
    volatile LAS unsigned* MISC = (volatile LAS unsigned*)(lds + LDS_WORK);
    unsigned char* ws = A.ws;
    const int wave0 = __builtin_amdgcn_readfirstlane((int)threadIdx.x >> 6);
    if (threadIdx.x < 64) MISC[threadIdx.x] = 0u;
    __syncthreads();
    XcdBarrier bar; bar.bar = (unsigned*)(ws + WS_CTL); bar.x = 0; bar.st = nullptr;
    if (A.use_bar) bar = xcd_barrier_post((unsigned*)(ws + WS_CTL), MISC);
#define GRID_BAR() do { if (A.use_bar) xcd_barrier(bar); else __syncthreads(); } while (0)
#define IN(k) (A.p_lo <= (k) && (k) < A.p_hi)
#define TIDS() int tid = wave0 * 64 + (int)__builtin_amdgcn_mbcnt_hi(~0u, __builtin_amdgcn_mbcnt_lo(~0u, 0u)); asm volatile("" : "+v"(tid)); const int lane = tid & 63, wave = __builtin_amdgcn_readfirstlane(tid >> 6); (void)lane; (void)wave
    float* rstat_all = (float*)(ws + WS_RSTAT);
    const float* cosT = (const float*)(ws + WS_COS); const float* sinT = (const float*)(ws + WS_SIN);
    float* agg = (float*)(ws + WS_AGG); float* carry = (float*)(ws + WS_CARRY);
    bf16_t* big = (bf16_t*)(ws + WS_BIG); bf16_t* st = (bf16_t*)(ws + WS_ST); bf16_t* lbuf = (bf16_t*)(ws + WS_LRU);

    { TIDS(); phase_convert(A, 0, lds, tid, lane, wave, 0, 6144, 3); GRID_BAR(); }
    for (int l = 0; l < DEPTH; ++l) {
        for (int h = 0; h < 2; ++h) {
            bf16_t* xb = (bf16_t*)(ws + WS_XB) + (size_t)h * HROWS * DM;
            float* rstat = rstat_all + h * HROWS;
            const int smask = h ? 8191 : 4095, nseq = h ? 4 : 8, Nc = h ? 64 : 32;
            bf16_t* mixb = (bf16_t*)(A.out + (size_t)h * HROWS * DM);
            bf16_t* fout = st;
            {
                const bool has_prev = (l > 0) || (h > 0);
                const int pl = h ? l : l - 1, ph = h ^ 1;
                bf16_t* pxb = (bf16_t*)(ws + WS_XB) + (size_t)ph * HROWS * DM; float* prs = rstat_all + ph * HROWS;
                const bool first = (blockIdx.x & 1) != 0;
                float* pxf = (pl == DEPTH - 1) ? A.out + (size_t)ph * HROWS * DM : nullptr;
                const bool cvt0 = (h == 0 && l == 0);
                if (cvt0 && (blockIdx.x & 1) != 0) { TIDS(); phase_convert(A, 0, lds, tid, lane, wave, 6144, 25344, 4); __syncthreads(); }
                const bool cvt_dn = (h == 0 && l > 0);
                if (has_prev && first) { TIDS(); phase_residual(pxb, st, A.in[24] + pl * DM, prs, pxf, lane, wave); if (cvt_dn) phase_convert(A, l, lds, tid, lane, wave, 19456, 25088, 0); __syncthreads(); }
                {
                    pg8::Gemm g{xb, (const bf16_t*)(ws + WS_WIN), HROWS, INW, DM}; pg8::StaticOrder S; S.init(HROWS, INW, (int)gridDim.x, (int)blockIdx.x, WGM_NARROW);
                    pg8::EpiProj E{big, rstat, cosT, sinT, smask};
                    pg8::gemm_phase<pg8::EpiProj, pg8::StaticOrder, true, true>(lds, g, S, E, wave0);
                }
                if (has_prev && !first) { TIDS(); phase_residual(pxb, st, A.in[24] + pl * DM, prs, pxf, lane, wave); if (cvt_dn) phase_convert(A, l, lds, tid, lane, wave, 19456, 25088, 0); }
                if (cvt0 && (blockIdx.x & 1) == 0) { TIDS(); phase_convert(A, 0, lds, tid, lane, wave, 6144, 25344, 4); }
                GRID_BAR();
            }
            {
                TIDS(); LruP P; P.conv_w = A.in[5] + l * 4 * 1024; P.conv_b = A.in[6] + l * 1024;
                P.ba[0] = A.in[8] + l * 1024; P.bx[0] = A.in[10] + l * 1024; P.lam[0] = A.in[11] + l * 1024;
                P.ba[1] = A.in[13] + l * 1024; P.bx[1] = A.in[15] + l * 1024; P.lam[1] = A.in[16] + l * 1024;
                for (int ck = blockIdx.x; ck < 256; ck += gridDim.x) {
                    l1_unit(lds, big, (const bf16_t*)(ws + WS_WLRU), lbuf, agg, P, ck, smask, tid);
                    b1_chunk(lds, big, st, ck, tid);
                }
                GRID_BAR();
            }
            { TIDS(); phase_scans(st, agg, carry, nseq, Nc, tid); GRID_BAR(); }
            {
                TIDS();
                for (int ck = blockIdx.x; ck < 256; ck += gridDim.x) b3_chunk(lds, big, st, mixb, A.in[4] + l * 1024, ck, tid);
                l3_rows(big, lbuf, carry, A.in[17] + l * 1024, mixb, lane, wave);
                GRID_BAR();
            }
            {
                pg8::Gemm g{mixb, (const bf16_t*)(ws + WS_WOUT), HROWS, DM, DM}; pg8::StaticOrder S; S.init(HROWS, DM, (int)gridDim.x, (int)blockIdx.x, WGM_NARROW);
                pg8::EpiBf16 E{big, DM};
                pg8::gemm_phase<pg8::EpiBf16, pg8::StaticOrder, true, true>(lds, g, S, E, wave0);
                GRID_BAR();
            }
            {
                TIDS();
                phase_residual(xb, big, A.in[19] + l * DM, rstat, nullptr, lane, wave);
                GRID_BAR();
            }
            {
                pg8::Gemm g{xb, (const bf16_t*)(ws + WS_WGU), HROWS, 2 * DFF, DM}; pg8::StaticOrder S; S.init(HROWS, 2 * DFF, (int)gridDim.x, (int)blockIdx.x, WGM_NARROW);
                pg8::EpiSwiGLU E{big, rstat};
                const bool cvt = (h == 1 && l + 1 < DEPTH), first = (blockIdx.x & 1) != 0;
                if (cvt && first) { TIDS(); phase_convert(A, l + 1, lds, tid, lane, wave, 0, 8192, 0); phase_convert(A, l + 1, lds, tid, lane, wave, 25088, 25344, 0); __syncthreads(); }
                pg8::gemm_phase<pg8::EpiSwiGLU, pg8::StaticOrder, true, true>(lds, g, S, E, wave0);
                if (cvt && !first) { TIDS(); phase_convert(A, l + 1, lds, tid, lane, wave, 0, 8192, 0); phase_convert(A, l + 1, lds, tid, lane, wave, 25088, 25344, 0); }
                GRID_BAR();
            }
            {
                pg8::Gemm g{big, (const bf16_t*)(ws + WS_WDN), HROWS, DM, DFF}; pg8::StaticOrder S; S.init(HROWS, DM, (int)gridDim.x, (int)blockIdx.x, WGM_NARROW);
                pg8::EpiBf16 E{fout, DM};
                const bool cvt = (h == 1 && l + 1 < DEPTH), first = (blockIdx.x & 1) != 0;
                if (cvt && first) { TIDS(); phase_convert(A, l + 1, lds, tid, lane, wave, 8192, 19456, 0); __syncthreads(); }
                pg8::gemm_phase<pg8::EpiBf16, pg8::StaticOrder, true, true>(lds, g, S, E, wave0);
                if (cvt && !first) { TIDS(); phase_convert(A, l + 1, lds, tid, lane, wave, 8192, 19456, 0); }
                GRID_BAR();
            }
        }
    }
    {
        TIDS(); phase_residual((bf16_t*)(ws + WS_XB) + (size_t)HROWS * DM, st, A.in[24] + (DEPTH - 1) * DM, rstat_all + HROWS, A.out + (size_t)HROWS * DM, lane, wave);
    }
#undef IN
#undef GRID_BAR
}

extern "C" void kernel_launch(void* const* d_in, const int* in_sizes, int n_in, void* d_out, int out_size, void* d_ws, size_t ws_size, hipStream_t stream) {
    static int grid = 0;
    if (grid == 0) {
        if (n_in != 25 || ws_size < WS_END || out_size != 2 * HROWS * DM) { fprintf(stderr, "kernel_launch: unexpected shapes (n_in %d, out %d, ws %zu; need ws >= %zu); nothing launched\n", n_in, out_size, ws_size, (size_t)WS_END); grid = -1; return; }
        int dev = 0, cus = 0, per_cu = 0;
        if (hipGetDevice(&dev) != hipSuccess || hipDeviceGetAttribute(&cus, hipDeviceAttributeMultiprocessorCount, dev) != hipSuccess) { grid = -1; return; }
        if (hipFuncSetAttribute((const void*)hymba_fwd, hipFuncAttributeMaxDynamicSharedMemorySize, LDS_BYTES) != hipSuccess) { fprintf(stderr, "kernel_launch: hipFuncSetAttribute failed\n"); grid = -1; return; }
        if (hipOccupancyMaxActiveBlocksPerMultiprocessor(&per_cu, (const void*)hymba_fwd, NTHR, LDS_BYTES) != hipSuccess || per_cu < 1) { fprintf(stderr, "kernel_launch: occupancy query reports %d blocks per CU\n", per_cu); (void)hipGetLastError(); grid = -1; return; }
        grid = cus;
    }
    if (grid < 0) return;
    (void)hipMemsetAsync((char*)d_ws + WS_CTL, 0, CTL_ZERO_BYTES, stream);
    Args a{};
    for (int i = 0; i < 25; ++i) a.in[i] = (const float*)d_in[i];
    a.out = (float*)d_out; a.ws = (unsigned char*)d_ws; a.pad = 0;
#if MK_ONE_LAUNCH
    a.l_lo = 0; a.l_hi = DEPTH; a.h_lo = 0; a.h_hi = 2; a.p_lo = 0; a.p_hi = NPH; a.use_bar = 1;
    hipLaunchKernelGGL(hymba_fwd, dim3(grid), dim3(NTHR), LDS_BYTES, stream, a);
#else
    a.use_bar = 0;
    for (int l = 0; l < DEPTH; ++l) for (int h = 0; h < 2; ++h) for (int p = (h == 0 ? 0 : 1); p < NPH; ++p) {
        a.l_lo = l; a.l_hi = l + 1; a.h_lo = h; a.h_hi = h + 1; a.p_lo = p; a.p_hi = p + 1;
        hipLaunchKernelGGL(hymba_fwd, dim3(grid), dim3(NTHR), LDS_BYTES, stream, a);
    }
#endif
}
```

```cpp
#include <hip/hip_runtime.h>
#include <cstdio>
#include <cstdint>

#ifndef MK_ONE_LAUNCH
#define MK_ONE_LAUNCH 1
#endif

namespace pg8 {
#define PG8_LAS __attribute__((address_space(3)))
typedef unsigned short bf16_t;
typedef short bf16x8 __attribute__((ext_vector_type(8)));
typedef float f32x4 __attribute__((ext_vector_type(4)));
typedef unsigned u32x4 __attribute__((ext_vector_type(4)));
constexpr int BM = 256, BK = 64, HALF = 128, HTB = HALF * BK * 2  , STAGE_BYTES = 8 * HTB, NXCD = 8, WGM = 8;

__host__ __device__ __forceinline__ int lds_byte(int r, int c) { const int st = (r >> 4) * 2 + (c >> 5), rr = r & 15, cc = c & 31, ob = rr * 64 + cc * 2; return st * 1024 + (ob ^ (((ob >> 9) & 1) << 5)); }
__host__ __device__ __forceinline__ void stage_rc(int b, int& R, int& C) { const int st = b / 1024, sb = b % 1024, swz = sb ^ (((sb >> 9) & 1) << 5); R = (st >> 1) * 16 + swz / 64; C = (st & 1) * 32 + (swz % 64) / 2; }
__host__ __device__ __forceinline__ int perm32(int rho) { const int n = rho >> 4, i = rho & 15; return 8 * (i >> 2) + 4 * n + (i & 3); }

struct Unit { int pm, pn, slot; };
struct Gemm { const bf16_t* A; const bf16_t* Bt; int M, N, K; };

struct StaticOrder {
    int nM, nN, nwg, G, c, wgm;
    __host__ __device__ void init(int M, int N, int G_, int c_, int wgm_ = WGM) { nM = M / BM; nN = N / BM; nwg = nM * nN; G = G_; c = c_; wgm = wgm_; }
    __host__ __device__ bool next(int i, Unit& u) const {
        const long L = (long)i * G + c; if (L >= nwg) return false;
        int wgid = (int)L; { const int q = nwg / NXCD, r = nwg % NXCD, xcd = wgid % NXCD, off = wgid / NXCD; wgid = (xcd < r ? xcd * (q + 1) : r * (q + 1) + (xcd - r) * q) + off; }
        const int nig = wgm * nN, gid = wgid / nig, fm = gid * wgm, gsz = (nM - fm) < wgm ? (nM - fm) : wgm;
        u.pm = fm + ((wgid % nig) % gsz); u.pn = (wgid % nig) / gsz; return true;
    }
    __device__ __forceinline__ void a_ready(const Unit&) const {}
    __device__ __forceinline__ void done(const Unit&) const {}
};

typedef float f32x2_ __attribute__((ext_vector_type(2)));
typedef __bf16 bf16x2_ __attribute__((ext_vector_type(2)));
__device__ __forceinline__ unsigned cvt_pk_bf16(float lo, float hi) { const f32x2_ v = {lo, hi}; const bf16x2_ r = __builtin_convertvector(v, bf16x2_); return __builtin_bit_cast(unsigned, r); }

struct EpiBf16 {
    static constexpr bool PERM = true, AFTER_DRAIN = false, PRE = false;
    bf16_t* O; int ldc;
    __device__ __forceinline__ void operator()(const f32x4 (&acc)[2][2][4][2], const Unit& u, int wr, int wc, int fr, int fq) const {
        const int row0 = u.pm * BM + wr * 64 + fr, col0 = u.pn * BM + wc * 32 + 8 * fq;
#pragma unroll
        for (int ai = 0; ai < 2; ++ai)
#pragma unroll
            for (int m = 0; m < 4; ++m) { bf16_t* rowp = O + (size_t)(row0 + ai * HALF + m * 16) * ldc + col0;
#pragma unroll
                for (int bj = 0; bj < 2; ++bj) { const f32x4 v0 = acc[ai][bj][m][0], v1 = acc[ai][bj][m][1];
                    u32x4 w; w.x = cvt_pk_bf16(v0[0], v0[1]); w.y = cvt_pk_bf16(v0[2], v0[3]); w.z = cvt_pk_bf16(v1[0], v1[1]); w.w = cvt_pk_bf16(v1[2], v1[3]);
                    *(u32x4*)(rowp + bj * HALF) = w; } }
    }
};
constexpr int RS_LDS_OFF = 144384;
__device__ __forceinline__ void rs_prefetch(PG8_LAS unsigned char* lds, const float* rstat, const Unit& u, int wid, int lane) {
    if (wid < 4) __builtin_amdgcn_global_load_lds((const unsigned*)(rstat + u.pm * BM + 64 * wid + lane), (PG8_LAS unsigned*)(lds + RS_LDS_OFF + u.slot * 1024 + wid * 256), 4, 0, 0);
}
struct EpiProj {
    static constexpr bool PERM = true, AFTER_DRAIN = false, PRE = true;
    bf16_t* O; const float* rstat; const float* cosT; const float* sinT; int smask; PG8_LAS unsigned char* lds;
    __device__ __forceinline__ void prefetch(const Unit& u, int wid, int lane) const { rs_prefetch(lds, rstat, u, wid, lane); }
    __device__ __forceinline__ void operator()(const f32x4 (&acc)[2][2][4][2], const Unit& u, int wr, int wc, int fr, int fq) const {
        const int row0 = u.pm * BM + wr * 64 + fr, col0 = u.pn * BM + wc * 32 + 8 * fq;
        if (u.pn < 8) {
            const int ti = 16 * wc + 4 * fq;
            const f32x4 cd = *(const f32x4*)(cosT + 16 * 64 + ti), sd = *(const f32x4*)(sinT + 16 * 64 + ti);
#pragma unroll
            for (int ai = 0; ai < 2; ++ai) { const int pos = (row0 + ai * HALF) & smask;
                f32x4 c4 = *(const f32x4*)(cosT + pos * 64 + ti), s4 = *(const f32x4*)(sinT + pos * 64 + ti);
#pragma unroll
                for (int m = 0; m < 4; ++m) { const int row = row0 + ai * HALF + m * 16; const float rs = *(const PG8_LAS float*)(lds + RS_LDS_OFF + u.slot * 1024 + (row - u.pm * BM) * 4);
                    bf16_t* rowp = O + (size_t)row * 6144 + col0;
#pragma unroll
                    for (int bj = 0; bj < 2; ++bj) { const f32x4 x1 = acc[ai][bj][m][0], x2 = acc[ai][bj][m][1];
                        const f32x4 v0 = (x1 * c4 - x2 * s4) * rs, v1 = (x2 * c4 + x1 * s4) * rs;
                        u32x4 w; w.x = cvt_pk_bf16(v0[0], v0[1]); w.y = cvt_pk_bf16(v0[2], v0[3]); w.z = cvt_pk_bf16(v1[0], v1[1]); w.w = cvt_pk_bf16(v1[2], v1[3]);
                        *(u32x4*)(rowp + bj * HALF) = w; }
                    if (m < 3) { const f32x4 cn = c4 * cd - s4 * sd, sn = s4 * cd + c4 * sd; c4 = cn; s4 = sn; } } }
        } else {
#pragma unroll
            for (int ai = 0; ai < 2; ++ai)
#pragma unroll
                for (int m = 0; m < 4; ++m) { const int row = row0 + ai * HALF + m * 16; const float rs = *(const PG8_LAS float*)(lds + RS_LDS_OFF + u.slot * 1024 + (row - u.pm * BM) * 4);
                    bf16_t* rowp = O + (size_t)row * 6144 + col0;
#pragma unroll
                    for (int bj = 0; bj < 2; ++bj) { const f32x4 v0 = acc[ai][bj][m][0] * rs, v1 = acc[ai][bj][m][1] * rs;
                        u32x4 w; w.x = cvt_pk_bf16(v0[0], v0[1]); w.y = cvt_pk_bf16(v0[2], v0[3]); w.z = cvt_pk_bf16(v1[0], v1[1]); w.w = cvt_pk_bf16(v1[2], v1[3]);
                        *(u32x4*)(rowp + bj * HALF) = w; } }
        }
    }
};
struct EpiSwiGLU {
    static constexpr bool PERM = true, AFTER_DRAIN = false, PRE = true;
    bf16_t* O; const float* rstat; PG8_LAS unsigned char* lds;
    __device__ __forceinline__ void prefetch(const Unit& u, int wid, int lane) const { rs_prefetch(lds, rstat, u, wid, lane); }
    __device__ __forceinline__ void operator()(const f32x4 (&acc)[2][2][4][2], const Unit& u, int wr, int wc, int fr, int fq) const {
        const int row0 = u.pm * BM + wr * 64 + fr, col0 = u.pn * HALF + wc * 32 + 8 * fq;
#pragma unroll
        for (int ai = 0; ai < 2; ++ai)
#pragma unroll
            for (int m = 0; m < 4; ++m) { const int row = row0 + ai * HALF + m * 16; const float rs = *(const PG8_LAS float*)(lds + RS_LDS_OFF + u.slot * 1024 + (row - u.pm * BM) * 4);
                float o[8];
#pragma unroll
                for (int n = 0; n < 2; ++n)
#pragma unroll
                    for (int j = 0; j < 4; ++j) { const float g = acc[ai][0][m][n][j] * rs, up = acc[ai][1][m][n][j] * rs;
                        o[n * 4 + j] = g * __builtin_amdgcn_rcpf(1.0f + __builtin_amdgcn_exp2f(-1.44269504089f * g)) * up; }
                u32x4 w; w.x = cvt_pk_bf16(o[0], o[1]); w.y = cvt_pk_bf16(o[2], o[3]); w.z = cvt_pk_bf16(o[4], o[5]); w.w = cvt_pk_bf16(o[6], o[7]);
                *(u32x4*)(O + (size_t)row * 5632 + col0) = w; }
    }
};

template <class Epi, class Sched, bool ALIGN_EPI = false, bool SP2 = false>
__device__ __forceinline__ void gemm_phase(PG8_LAS unsigned char* lds, const Gemm g, const Sched& S, const Epi& E, int wave_in) {
    int tid_ = wave_in * 64 + (int)__builtin_amdgcn_mbcnt_hi(~0u, __builtin_amdgcn_mbcnt_lo(~0u, 0u)); asm volatile("" : "+v"(tid_));
    const int tid = tid_, wid = __builtin_amdgcn_readfirstlane(tid >> 6), lane = tid & 63, wr = wid >> 2, wc = wid & 3, fr = lane & 15, fq = lane >> 4;
    const int K = g.K, nt = K / BK;
    unsigned voffA[2], voffB[2];
#pragma unroll
    for (int i = 0; i < 2; ++i) { int R, C; stage_rc(tid * 16 + i * 8192, R, C); const int Rb = Epi::PERM ? ((R & ~31) + perm32(R & 31)) : R;
        voffA[i] = (unsigned)(R * K + C) * 2u; voffB[i] = (unsigned)(Rb * K + C) * 2u; }
    const size_t kstep = (size_t)(BK * 2);
    const size_t hstep = (size_t)HALF * K * 2;
    const size_t tstep = 2 * hstep;
    const unsigned ldsw = (unsigned)wid * 1024u;
    const int aoff = lds_byte(wr * 64 + fr, fq * 8), boff = lds_byte(wc * 32 + fr, fq * 8);
#define PG8_SA(b, h) (((b) * 2 + (h)) * HTB)
#define PG8_SB(b, h) ((4 + (b) * 2 + (h)) * HTB)
#define PG8_STAGE(bufoff, gbase, voff) do { _Pragma("unroll") for (int _i = 0; _i < 2; ++_i) \
        __builtin_amdgcn_global_load_lds((const unsigned*)((const char*)(gbase) + (voff)[_i]), (PG8_LAS unsigned*)(lds + (bufoff) + ldsw + _i * 8192), 16, 0, 0); } while (0)
#define PG8_LDA(dst, b, h) do { _Pragma("unroll") for (int m = 0; m < 4; ++m) _Pragma("unroll") for (int k = 0; k < 2; ++k) dst[m][k] = *(const PG8_LAS bf16x8*)(lds + PG8_SA(b, h) + aoff + m * 2048 + k * 1024); } while (0)
#define PG8_LDB(dst, b, h) do { _Pragma("unroll") for (int n = 0; n < 2; ++n) _Pragma("unroll") for (int k = 0; k < 2; ++k) dst[n][k] = *(const PG8_LAS bf16x8*)(lds + PG8_SB(b, h) + boff + n * 2048 + k * 1024); } while (0)
#define PG8_MMA(ai, bj, At, Bt) do { __builtin_amdgcn_s_setprio(1); _Pragma("unroll") for (int m = 0; m < 4; ++m) _Pragma("unroll") for (int n = 0; n < 2; ++n) _Pragma("unroll") for (int k = 0; k < 2; ++k) \
        acc[ai][bj][m][n] = __builtin_amdgcn_mfma_f32_16x16x32_bf16(Bt[n][k], At[m][k], acc[ai][bj][m][n], 0, 0, 0); __builtin_amdgcn_s_setprio(0); } while (0)
#define PG8_WAIT_V(n) asm volatile("s_waitcnt vmcnt(" #n ")" ::: "memory")
#define PG8_WAIT_L(n) asm volatile("s_waitcnt lgkmcnt(" #n ")" ::: "memory")
#define PG8_BAR __builtin_amdgcn_s_barrier()
#define PG8_SCHED __builtin_amdgcn_sched_barrier(0)
    Unit cur, nxt; int ui = 0;
    if (!S.next(0, cur)) return;
    cur.slot = 0; nxt.slot = 1;
    if constexpr (Epi::PRE) E.prefetch(cur, wid, lane);
    f32x4 acc[2][2][4][2];
#pragma unroll
    for (int a = 0; a < 2; ++a)
#pragma unroll
        for (int b = 0; b < 2; ++b)
#pragma unroll
            for (int m = 0; m < 4; ++m)
#pragma unroll
                for (int n = 0; n < 2; ++n) acc[a][b][m][n] = (f32x4){0.f, 0.f, 0.f, 0.f};
    bf16x8 At[4][2], B0[2][2], B1[2][2];
    const char* cA = (const char*)g.A + (size_t)cur.pm * tstep; const char* cB = (const char*)g.Bt + (size_t)cur.pn * tstep;
    S.a_ready(cur);
    if constexpr (SP2) {
        PG8_STAGE(PG8_SB(0, 0), cB, voffB); PG8_STAGE(PG8_SB(0, 1), cB + hstep, voffB); PG8_STAGE(PG8_SA(0, 0), cA, voffA); PG8_STAGE(PG8_SA(0, 1), cA + hstep, voffA);
        if (wr == 1) PG8_BAR;
        PG8_WAIT_V(2); PG8_BAR;
        PG8_STAGE(PG8_SB(1, 0), cB + kstep, voffB); PG8_STAGE(PG8_SA(1, 0), cA + kstep, voffA); PG8_STAGE(PG8_SB(1, 1), cB + hstep + kstep, voffB);
        PG8_WAIT_V(6); PG8_BAR;
    } else {
        PG8_STAGE(PG8_SB(0, 0), cB, voffB); PG8_STAGE(PG8_SA(0, 0), cA, voffA); PG8_STAGE(PG8_SB(0, 1), cB + hstep, voffB); PG8_STAGE(PG8_SA(0, 1), cA + hstep, voffA);
        if (wr == 1) PG8_BAR;
        PG8_WAIT_V(4); PG8_BAR;
        PG8_STAGE(PG8_SB(1, 0), cB + kstep, voffB); PG8_STAGE(PG8_SA(1, 0), cA + kstep, voffA); PG8_STAGE(PG8_SB(1, 1), cB + hstep + kstep, voffB);
        PG8_WAIT_V(6); PG8_BAR;
    }
    for (;;) {
        const bool has_next = S.next(ui + 1, nxt);
        const char* nA = has_next ? (const char*)g.A + (size_t)nxt.pm * tstep : cA; const char* nB = has_next ? (const char*)g.Bt + (size_t)nxt.pn * tstep : cB;
        for (int t = 0; t < nt; t += 2) {
            const bool last = (t == nt - 2);
            const char* a1 = cA + (size_t)(t + 1) * kstep;
            const char* a2 = last ? nA : cA + (size_t)(t + 2) * kstep; const char* b2 = last ? nB : cB + (size_t)(t + 2) * kstep;
            const char* a3 = a2 + kstep; const char* b3 = b2 + kstep;
            if (last && has_next) S.a_ready(nxt);
            if constexpr (SP2) {
            PG8_LDB(B0, 0, 0); PG8_LDB(B1, 0, 1); PG8_SCHED; PG8_LDA(At, 0, 0); PG8_STAGE(PG8_SA(1, 1), a1 + hstep, voffA);
            PG8_WAIT_V(8); PG8_WAIT_L(0); PG8_BAR; PG8_MMA(0, 0, At, B0); PG8_MMA(0, 1, At, B1); PG8_BAR; PG8_SCHED;
            PG8_LDA(At, 0, 1); PG8_STAGE(PG8_SB(0, 0), b2, voffB); PG8_STAGE(PG8_SB(0, 1), b2 + hstep, voffB); PG8_STAGE(PG8_SA(0, 0), a2, voffA);
            PG8_WAIT_V(8); PG8_WAIT_L(0); PG8_BAR; PG8_MMA(1, 0, At, B0); PG8_MMA(1, 1, At, B1); PG8_BAR; PG8_SCHED;
            PG8_LDB(B0, 1, 0); PG8_LDB(B1, 1, 1); PG8_SCHED; PG8_LDA(At, 1, 0); PG8_STAGE(PG8_SA(0, 1), a2 + hstep, voffA);
            PG8_WAIT_V(8); PG8_WAIT_L(0); PG8_BAR; PG8_MMA(0, 0, At, B0); PG8_MMA(0, 1, At, B1); PG8_BAR; PG8_SCHED;
            PG8_LDA(At, 1, 1); PG8_STAGE(PG8_SB(1, 0), b3, voffB); PG8_STAGE(PG8_SB(1, 1), b3 + hstep, voffB); PG8_STAGE(PG8_SA(1, 0), a3, voffA);
            PG8_WAIT_V(8); PG8_WAIT_L(0); PG8_BAR; PG8_MMA(1, 0, At, B0); PG8_MMA(1, 1, At, B1); PG8_BAR; PG8_SCHED;
            } else {
            PG8_LDB(B0, 0, 0); PG8_SCHED; PG8_LDA(At, 0, 0); PG8_STAGE(PG8_SA(1, 1), a1 + hstep, voffA);
            PG8_WAIT_L(8); PG8_BAR; PG8_WAIT_L(0); PG8_MMA(0, 0, At, B0); PG8_BAR; PG8_SCHED;
            PG8_LDB(B1, 0, 1); PG8_STAGE(PG8_SB(0, 0), b2, voffB);
            PG8_BAR; PG8_WAIT_L(0); PG8_MMA(0, 1, At, B1); PG8_BAR;
            PG8_LDA(At, 0, 1); PG8_STAGE(PG8_SA(0, 0), a2, voffA);
            PG8_BAR; PG8_WAIT_L(0); PG8_MMA(1, 0, At, B0); PG8_BAR; PG8_SCHED;
            PG8_STAGE(PG8_SB(0, 1), b2 + hstep, voffB);
            PG8_WAIT_V(6); PG8_BAR; PG8_MMA(1, 1, At, B1); PG8_BAR;
            PG8_LDB(B0, 1, 0); PG8_SCHED; PG8_LDA(At, 1, 0); PG8_STAGE(PG8_SA(0, 1), a2 + hstep, voffA);
            PG8_WAIT_L(8); PG8_BAR; PG8_WAIT_L(0); PG8_MMA(0, 0, At, B0); PG8_BAR; PG8_SCHED;
            PG8_LDB(B1, 1, 1); PG8_STAGE(PG8_SB(1, 0), b3, voffB);
            PG8_BAR; PG8_WAIT_L(0); PG8_MMA(0, 1, At, B1); PG8_BAR;
            PG8_LDA(At, 1, 1); PG8_STAGE(PG8_SA(1, 0), a3, voffA);
            PG8_BAR; PG8_WAIT_L(0); PG8_MMA(1, 0, At, B0); PG8_BAR; PG8_SCHED;
            PG8_STAGE(PG8_SB(1, 1), b3 + hstep, voffB);
            PG8_WAIT_V(6); PG8_BAR; PG8_MMA(1, 1, At, B1); PG8_BAR;
            }
        }
        if constexpr (ALIGN_EPI) { if (wr == 0) PG8_BAR; }
        if constexpr (!Epi::AFTER_DRAIN) { E(acc, cur, wr, wc, fr, fq); S.done(cur); }
        if constexpr (Epi::PRE) { nxt.slot = cur.slot ^ 1; if (has_next) E.prefetch(nxt, wid, lane); }
        if (!has_next) break;
#pragma unroll
        for (int a = 0; a < 2; ++a)
#pragma unroll
            for (int b = 0; b < 2; ++b)
#pragma unroll
                for (int m = 0; m < 4; ++m)
#pragma unroll
                    for (int n = 0; n < 2; ++n) acc[a][b][m][n] = (f32x4){0.f, 0.f, 0.f, 0.f};
        cur = nxt; cA = nA; cB = nB; ++ui;
        if constexpr (ALIGN_EPI) { if (wr == 1) PG8_BAR; }
    }
    PG8_WAIT_V(0);
    if constexpr (!ALIGN_EPI) { if (wr == 0) PG8_BAR; }
    PG8_BAR;
    if constexpr (Epi::AFTER_DRAIN) { E.fused(acc, cur, wr, wc, fr, fq, lds, wid, lane); S.done(cur); }
#undef PG8_SA
#undef PG8_SB
#undef PG8_STAGE
#undef PG8_LDA
#undef PG8_LDB
#undef PG8_MMA
#undef PG8_WAIT_V
#undef PG8_WAIT_L
#undef PG8_BAR
#undef PG8_SCHED
}
}


#define GAS __attribute__((address_space(1)))
#define LAS __attribute__((address_space(3)))
typedef unsigned short bf16_t;
typedef float f32x4 __attribute__((ext_vector_type(4)));
typedef short s16x4 __attribute__((ext_vector_type(4)));
typedef short s16x8 __attribute__((ext_vector_type(8)));
typedef unsigned u32x4 __attribute__((ext_vector_type(4)));
typedef unsigned u32x2 __attribute__((ext_vector_type(2)));

constexpr int NWAVES = 8, NTHR = 512;
constexpr int DM = 2048, DEPTH = 4, HROWS = 32768, INW = 6144, DFF = 5632, LRUW = 1024;
constexpr float EPS = 1e-6f;
constexpr int NPH = 10;

constexpr size_t MiB = 1u << 20;
constexpr size_t WS_CTL = 0, CTL_ZERO_BYTES = 64 * 1024;
constexpr size_t WS_RSTAT = 1 * MiB;
constexpr size_t WS_COS = 2 * MiB, WS_SIN = 4 * MiB;
constexpr size_t WS_AGG = 6 * MiB;
constexpr size_t WS_CARRY = 10 * MiB;
constexpr size_t WS_WIN = 16 * MiB;
constexpr size_t WS_WOUT = 40 * MiB;
constexpr size_t WS_WGU = 48 * MiB;
constexpr size_t WS_WDN = 92 * MiB;
constexpr size_t WS_WLRU = 114 * MiB;
constexpr size_t WS_XB = 116 * MiB;
constexpr size_t WS_BIG = 372 * MiB;
constexpr size_t WS_ST = 756 * MiB;
constexpr size_t WS_LRU = 884 * MiB;
constexpr size_t WS_END = 1076 * MiB;
constexpr int LDS_WORK = 139264, LDS_BYTES = LDS_WORK + 1024 + 4096 + 2048;
static_assert(LDS_WORK + 1024 + 4096 == pg8::RS_LDS_OFF, "row-statistic slots");

#define LDS_WAIT() asm volatile("s_waitcnt lgkmcnt(0)" ::: "memory")

__device__ __forceinline__ unsigned pk2(float lo, float hi) { return pg8::cvt_pk_bf16(lo, hi); }
__device__ __forceinline__ float bflo(unsigned w) { return __uint_as_float(w << 16); }
__device__ __forceinline__ float bfhi(unsigned w) { return __uint_as_float(w & 0xffff0000u); }
__device__ __forceinline__ float wave_sum(float v) {
#pragma unroll
    for (int o = 1; o < 64; o <<= 1) v += __shfl_xor(v, o);
    return v;
}
__device__ __forceinline__ float fexp2(float x) { return __builtin_amdgcn_exp2f(x); }
__device__ __forceinline__ float fsigmoid(float x) { return __builtin_amdgcn_rcpf(1.0f + fexp2(-1.44269504089f * x)); }

__device__ __forceinline__ unsigned off_b(unsigned row, unsigned ch) { return 256u * row + 16u * (ch ^ (((row & 3u) << 2) | ((row >> 2) & 3u))); }
__device__ __forceinline__ s16x8 row_frag(LAS unsigned char* img, int rb, int ks, int lane) { return *(LAS s16x8*)(img + off_b((unsigned)((lane & 15) + 16 * rb), (unsigned)(4 * ks + (lane >> 4)))); }
__device__ __forceinline__ s16x8 tr_frag(LAS unsigned char* img, int c, int ks, int lane) {
    const unsigned g = (unsigned)lane >> 4, q = ((unsigned)lane & 15u) >> 2, p = (unsigned)lane & 3u, row = 32u * ks + 8u * g + q, ch = 2u * c + (p >> 1);
    const s16x4 lo = __builtin_amdgcn_ds_read_tr16_b64_v4i16((LAS s16x4*)(img + off_b(row, ch) + 8u * (p & 1u)));
    const s16x4 hi = __builtin_amdgcn_ds_read_tr16_b64_v4i16((LAS s16x4*)(img + off_b(row + 4u, ch) + 8u * (p & 1u)));
    return __builtin_shufflevector(lo, hi, 0, 1, 2, 3, 4, 5, 6, 7);
}
#define MFMA16(a, b, c) __builtin_amdgcn_mfma_f32_16x16x32_bf16((a), (b), (c), 0, 0, 0)

#define XB_TMO      128
#define XB_XCNT(j)  (256  + 64 * (j))
#define XB_XSUB(j)  (1280 + 64 * (j))
#define XB_XGEN(j)  (2304 + 64 * (j))
#define XB_TOP      3328
#define XB_TOPGEN   3392
#define XCD_BAR_WORDS 3456
#define XB_SPIN_CAP (1u << 18)

__device__ __forceinline__ unsigned xb_ld(unsigned* p)              { return __hip_atomic_load(p, __ATOMIC_RELAXED, __HIP_MEMORY_SCOPE_AGENT); }
__device__ __forceinline__ unsigned xb_add(unsigned* p, unsigned v) { return __hip_atomic_fetch_add(p, v, __ATOMIC_RELAXED, __HIP_MEMORY_SCOPE_AGENT); }
__device__ __forceinline__ unsigned xb_xcc_id() { return (unsigned)__builtin_amdgcn_s_getreg((3 << 11) | 20) & 0xFu; }
#define XB_SPIN(cond, bar) do { unsigned _sp = 0; while (cond) { __builtin_amdgcn_s_sleep(1); \
    if ((++_sp & 255u) == 0u) { if (xb_ld(&(bar)[XB_TMO])) break; if (_sp > XB_SPIN_CAP) { atomicAdd(&(bar)[XB_TMO], 1u); break; } } } } while (0)

struct XcdBarrier {
    unsigned* bar; unsigned x;
    volatile LAS unsigned* st;
};

__device__ __forceinline__ XcdBarrier xcd_barrier_post(unsigned* bar, volatile LAS unsigned* st) {
    XcdBarrier b; b.bar = bar; b.x = xb_xcc_id(); b.st = st;
    if (threadIdx.x == 0) (void)xb_add(&bar[XB_XCNT(b.x)], 1u);
    return b;
}
__device__ __forceinline__ void xcd_barrier_complete(unsigned* bar, unsigned x, unsigned& nloc, unsigned& nx) {
    const unsigned G = gridDim.x * gridDim.y * gridDim.z;
    unsigned sum, cnt, mine, sp = 0u;
    for (;;) {
        sum = 0u; cnt = 0u; mine = 0u;
#pragma unroll
        for (unsigned j = 0; j < 16; ++j) { const unsigned c = xb_ld(&bar[XB_XCNT(j)]); sum += c; cnt += (c > 0u) ? 1u : 0u; mine = (j == x) ? c : mine; }
        if (sum == G) break;
        __builtin_amdgcn_s_sleep(1);
        if ((++sp & 255u) == 0u) { if (xb_ld(&bar[XB_TMO])) break; if (sp > XB_SPIN_CAP) { atomicAdd(&bar[XB_TMO], 1u); break; } }
    }
    nloc = mine > 0u ? mine : 1u; nx = cnt > 0u ? cnt : 1u;
}

__device__ __forceinline__ void xcd_barrier(const XcdBarrier& b) {
    asm volatile("s_waitcnt vmcnt(0)" ::: "memory");
    __syncthreads();
    if (threadIdx.x == 0) {
        unsigned* bar = b.bar;
        __builtin_amdgcn_s_waitcnt(0);
        unsigned nloc = b.st[0], nx = b.st[1];
        if (nloc == 0u) { xcd_barrier_complete(bar, b.x, nloc, nx); b.st[0] = nloc; b.st[1] = nx; }
        const unsigned old = xb_add(&bar[XB_XSUB(b.x)], 1u);
        const unsigned gen = old / nloc;
        if (old + 1u == (gen + 1u) * nloc) {
            __builtin_amdgcn_fence(__ATOMIC_RELEASE, "agent");
            asm volatile("s_waitcnt vmcnt(0)" ::: "memory");
            const unsigned og = xb_add(&bar[XB_TOP], 1u);
            const unsigned tg = og / nx;
            if (og + 1u == (tg + 1u) * nx) xb_add(&bar[XB_TOPGEN], 1u);
            else XB_SPIN(xb_ld(&bar[XB_TOPGEN]) == tg, bar);
            __builtin_amdgcn_fence(__ATOMIC_ACQUIRE, "agent");
            xb_add(&bar[XB_XGEN(b.x)], 1u);
            asm volatile("s_waitcnt vmcnt(0)" ::: "memory");
        } else {
            XB_SPIN(xb_ld(&bar[XB_XGEN(b.x)]) == gen, bar);
            __builtin_amdgcn_fence(__ATOMIC_ACQUIRE, "agent");
            asm volatile("s_waitcnt vmcnt(0)" ::: "memory");
        }
    }
    __syncthreads();
}
struct Args { const float* in[25]; float* out; unsigned char* ws; int l_lo, l_hi, h_lo, h_hi, p_lo, p_hi, use_bar, pad; };

__device__ __forceinline__ void cvt_tile(const float* colp, int ldw, const float* gain, float nsc, int k0, bf16_t* dst, int K, LAS float* scr, int lane) {
#pragma unroll
    for (int i = 0; i < 32; ++i) { const int kk = 2 * i + (lane >> 5); const float g = gain ? gain[k0 + kk] * nsc : nsc; scr[kk * 33 + (lane & 31)] = colp[(size_t)(k0 + kk) * ldw] * g; }
    LDS_WAIT(); asm volatile("" ::: "memory");
    const int c = lane & 7;
#pragma unroll
    for (int j = 0; j < 4; ++j) { const int n = (lane >> 3) + 8 * j; const LAS float* s = scr + (8 * c) * 33 + n;
        u32x4 o; o.x = pk2(s[0 * 33], s[1 * 33]); o.y = pk2(s[2 * 33], s[3 * 33]); o.z = pk2(s[4 * 33], s[5 * 33]); o.w = pk2(s[6 * 33], s[7 * 33]);
        *(u32x4*)(dst + (size_t)n * K + 8 * c) = o; }
    LDS_WAIT(); asm volatile("" ::: "memory");
}
__device__ __forceinline__ void phase_convert(const Args& A, int l, LAS unsigned char* lds, int tid, int lane, int wave, int it_lo, int it_hi, int prologue) {
    unsigned char* ws = A.ws;
    LAS float* scr = (LAS float*)(lds + wave * 16384);
    const int gw = blockIdx.x * NWAVES + wave, NGW = gridDim.x * NWAVES;
    constexpr int I_WIN = 32 * 192, I_WOUT = 32 * 64, I_WGU = 32 * 352, I_WDN = 88 * 64, I_LRU = 256;
    constexpr int NITEMS = I_WIN + I_WOUT + I_WGU + I_WDN + I_LRU;
    static_assert(NITEMS == 25344, "item list");
    for (int it = it_lo + gw; it < it_hi; it += NGW) {
        int r = it;
        if (r < I_WIN) { const int kb = r / 192, nb = r % 192, n = 32 * nb + (lane & 31); int src = n; float nsc = 1.f;
            if (n < 2048) { const int sec = n >> 10, w = n & 1023, head = w >> 7, p = w & 127; src = sec * 1024 + head * 128 + 64 * ((p >> 2) & 1) + 16 * (p >> 5) + 4 * ((p >> 3) & 3) + (p & 3); nsc = sec ? 0.08838834764831845f : 1.f; }
            cvt_tile(A.in[3] + (size_t)l * 2048 * 6144 + src, 6144, A.in[2] + l * 2048, nsc, 64 * kb, (bf16_t*)(ws + WS_WIN) + (size_t)(32 * nb) * 2048 + 64 * kb, 2048, scr, lane); continue; }
        r -= I_WIN;
        if (r < I_WOUT) { const int kb = r / 64, nb = r % 64, n = 32 * nb + (lane & 31);
            cvt_tile(A.in[18] + (size_t)l * 2048 * 2048 + n, 2048, nullptr, 1.f, 64 * kb, (bf16_t*)(ws + WS_WOUT) + (size_t)(32 * nb) * 2048 + 64 * kb, 2048, scr, lane); continue; }
        r -= I_WOUT;
        if (r < I_WGU) { const int kb = r / 352, nb = r % 352, n = 32 * nb + (lane & 31); const int pn = n >> 8, bj = (n >> 7) & 1, c = n & 127;
            const float* W = (bj ? A.in[22] : A.in[21]) + (size_t)l * 2048 * 5632 + 128 * pn + c;
            cvt_tile(W, 5632, A.in[20] + l * 2048, 1.f, 64 * kb, (bf16_t*)(ws + WS_WGU) + (size_t)(32 * nb) * 2048 + 64 * kb, 2048, scr, lane); continue; }
        r -= I_WGU;
        if (r < I_WDN) { const int kb = r / 64, nb = r % 64, n = 32 * nb + (lane & 31);
            cvt_tile(A.in[23] + (size_t)l * 5632 * 2048 + n, 2048, nullptr, 1.f, 64 * kb, (bf16_t*)(ws + WS_WDN) + (size_t)(32 * nb) * 5632 + 64 * kb, 5632, scr, lane); continue; }
        r -= I_WDN;
        { const int mat = r >> 3, g = mat >> 2, gate = mat & 3, sub = r & 7, kb = sub >> 2, nb = sub & 3, n = 32 * nb + (lane & 31);
            const float* W = (gate == 0 ? A.in[7] : gate == 1 ? A.in[9] : gate == 2 ? A.in[12] : A.in[14]) + (size_t)(l * 8 + g) * 128 * 128 + n;
            cvt_tile(W, 128, nullptr, 1.f, 64 * kb, (bf16_t*)(ws + WS_WLRU) + (size_t)(mat * 128 + 32 * nb) * 128 + 64 * kb, 128, scr, lane); }
    }
    if (prologue & 1) {
        float* cosT = (float*)(ws + WS_COS); float* sinT = (float*)(ws + WS_SIN);
        for (int i = blockIdx.x * NTHR + tid; i < 8192 * 64; i += gridDim.x * NTHR) { const int pos = i >> 6, j = i & 63;
            const float inv = __builtin_amdgcn_exp2f(-(float)j * 0.20762050593046014f); const float ang = (float)pos * inv;
            const double rev = (double)ang * 0.15915494309189535; const float fr = (float)(rev - floor(rev));
            cosT[i] = __builtin_amdgcn_cosf(fr); sinT[i] = __builtin_amdgcn_sinf(fr); }
    }
    if (prologue & 6) {
        float* rstat = (float*)(ws + WS_RSTAT); bf16_t* xb = (bf16_t*)(ws + WS_XB);
        const int m_lo = (prologue & 2) ? 0 : HROWS, m_hi = (prologue & 4) ? 2 * HROWS : HROWS;
        for (int m = m_lo + gw; m < m_hi; m += NGW) {
            const float* xr = (m < HROWS ? A.in[0] + (size_t)m * DM : A.in[1] + (size_t)(m - HROWS) * DM);
            f32x4 v[8]; float ss = 0.f;
#pragma unroll
            for (int j = 0; j < 8; ++j) { v[j] = ((const f32x4*)xr)[lane + 64 * j]; ss += (v[j][0] * v[j][0] + v[j][1] * v[j][1]) + (v[j][2] * v[j][2] + v[j][3] * v[j][3]); }
            ss = wave_sum(ss);
            u32x2* o = (u32x2*)(xb + (size_t)m * DM);
#pragma unroll
            for (int j = 0; j < 8; ++j) { u32x2 w; w.x = pk2(v[j][0], v[j][1]); w.y = pk2(v[j][2], v[j][3]); o[lane + 64 * j] = w; }
            if (lane == 0) rstat[m] = 1.0f / sqrtf(ss * (1.0f / DM) + EPS);
        }
    }
}

__device__ __forceinline__ void phase_residual(bf16_t* xb, const bf16_t* br, const float* gain, float* rstat, float* xf32, int lane, int wave) {
    const int gw = blockIdx.x * NWAVES + wave, NGW = gridDim.x * NWAVES;
    f32x4 g[8];
#pragma unroll
    for (int j = 0; j < 4; ++j) { g[2 * j] = ((const f32x4*)gain)[2 * (lane + 64 * j)]; g[2 * j + 1] = ((const f32x4*)gain)[2 * (lane + 64 * j) + 1]; }
    u32x4 bn[4], xn[4];
    if (gw < HROWS) {
#pragma unroll
        for (int j = 0; j < 4; ++j) { bn[j] = ((const u32x4*)(br + (size_t)gw * DM))[lane + 64 * j]; xn[j] = ((const u32x4*)(xb + (size_t)gw * DM))[lane + 64 * j]; } }
#pragma unroll 1
    for (int m = gw; m < HROWS; m += NGW) {
        u32x4* xp = (u32x4*)(xb + (size_t)m * DM);
        u32x4 b[4], xv[4]; float ss = 0.f;
#pragma unroll
        for (int j = 0; j < 4; ++j) { b[j] = bn[j]; xv[j] = xn[j]; }
        if (m + NGW < HROWS) {
#pragma unroll
            for (int j = 0; j < 4; ++j) { bn[j] = ((const u32x4*)(br + (size_t)(m + NGW) * DM))[lane + 64 * j]; xn[j] = ((const u32x4*)(xb + (size_t)(m + NGW) * DM))[lane + 64 * j]; } }
        f32x4 f[8], x[8];
#pragma unroll
        for (int j = 0; j < 4; ++j) { f[2 * j] = (f32x4){bflo(b[j].x), bfhi(b[j].x), bflo(b[j].y), bfhi(b[j].y)}; f[2 * j + 1] = (f32x4){bflo(b[j].z), bfhi(b[j].z), bflo(b[j].w), bfhi(b[j].w)};
            x[2 * j] = (f32x4){bflo(xv[j].x), bfhi(xv[j].x), bflo(xv[j].y), bfhi(xv[j].y)}; x[2 * j + 1] = (f32x4){bflo(xv[j].z), bfhi(xv[j].z), bflo(xv[j].w), bfhi(xv[j].w)}; }
#pragma unroll
        for (int j = 0; j < 8; ++j) ss += (f[j][0] * f[j][0] + f[j][1] * f[j][1]) + (f[j][2] * f[j][2] + f[j][3] * f[j][3]);
        const float s = 1.0f / sqrtf(wave_sum(ss) * (1.0f / DM) + EPS);
        float s2 = 0.f;
#pragma unroll
        for (int j = 0; j < 8; ++j) { x[j] = x[j] + f[j] * s * g[j]; s2 += (x[j][0] * x[j][0] + x[j][1] * x[j][1]) + (x[j][2] * x[j][2] + x[j][3] * x[j][3]); }
        if (xf32) { f32x4* op = (f32x4*)(xf32 + (size_t)m * DM);
#pragma unroll
            for (int j = 0; j < 4; ++j) { op[2 * (lane + 64 * j)] = x[2 * j]; op[2 * (lane + 64 * j) + 1] = x[2 * j + 1]; }
        } else {
            s2 = wave_sum(s2);
#pragma unroll
            for (int j = 0; j < 4; ++j) { u32x4 w; w.x = pk2(x[2 * j][0], x[2 * j][1]); w.y = pk2(x[2 * j][2], x[2 * j][3]); w.z = pk2(x[2 * j + 1][0], x[2 * j + 1][1]); w.w = pk2(x[2 * j + 1][2], x[2 * j + 1][3]); xp[lane + 64 * j] = w; }
            if (lane == 0) rstat[m] = 1.0f / sqrtf(s2 * (1.0f / DM) + EPS);
        }
    }
}
__device__ __forceinline__ float head_l2g(int head) { return __builtin_log2f(1.0f - __builtin_exp2f(-5.0f - (float)head)); }

__device__ __forceinline__ void b1_chunk(LAS unsigned char* lds, const bf16_t* proj, bf16_t* st, int ck, int tid_in) {
    LAS unsigned char* imV = lds; LAS unsigned char* imKf = lds + 32768; LAS unsigned char* imKb = lds + 65536;
    u32x4 pf[8];
    {   int tid = tid_in; asm volatile("" : "+v"(tid)); const bf16_t* Kg = proj + (size_t)(ck * 128) * INW + 1024;
#pragma unroll
        for (int i = 0; i < 4; ++i) { const int q = tid + 512 * i, row = q >> 4, ch = q & 15; pf[i] = *(const u32x4*)(Kg + (size_t)row * INW + ch * 8); pf[4 + i] = *(const u32x4*)(Kg + 1024 + (size_t)row * INW + ch * 8); } }
#pragma unroll 1
    for (int head = 0; head < 8; ++head) {
        int tid = tid_in; asm volatile("" : "+v"(tid)); const int lane = tid & 63, wid = __builtin_amdgcn_readfirstlane(tid >> 6);
        const float l2g = head_l2g(head);
        __syncthreads();
#pragma unroll
        for (int i = 0; i < 4; ++i) { const int q = tid + 512 * i, row = q >> 4, ch = q & 15; const u32x4 kv = pf[i];
            const float sf = fexp2(l2g * (float)(127 - row)), sb = fexp2(l2g * (float)row); const unsigned off = off_b(row, ch);
            *(LAS u32x4*)(imV + off) = pf[4 + i];
            u32x4 kf, kb;
            kf.x = pk2(bflo(kv.x) * sf, bfhi(kv.x) * sf); kf.y = pk2(bflo(kv.y) * sf, bfhi(kv.y) * sf); kf.z = pk2(bflo(kv.z) * sf, bfhi(kv.z) * sf); kf.w = pk2(bflo(kv.w) * sf, bfhi(kv.w) * sf);
            kb.x = pk2(bflo(kv.x) * sb, bfhi(kv.x) * sb); kb.y = pk2(bflo(kv.y) * sb, bfhi(kv.y) * sb); kb.z = pk2(bflo(kv.z) * sb, bfhi(kv.z) * sb); kb.w = pk2(bflo(kv.w) * sb, bfhi(kv.w) * sb);
            *(LAS u32x4*)(imKf + off) = kf; *(LAS u32x4*)(imKb + off) = kb; }
        __syncthreads();
        if (head < 7) { const bf16_t* Kg = proj + (size_t)(ck * 128) * INW + 1024 + (head + 1) * 128;
#pragma unroll
            for (int i = 0; i < 4; ++i) { const int q = tid + 512 * i, row = q >> 4, ch = q & 15; pf[i] = *(const u32x4*)(Kg + (size_t)row * INW + ch * 8); pf[4 + i] = *(const u32x4*)(Kg + 1024 + (size_t)row * INW + ch * 8); } }
        const int wr = wid >> 2, wc = wid & 3, fr = lane & 15, fq = lane >> 4;
        f32x4 accf[4][2], accb[4][2];
#pragma unroll
        for (int a = 0; a < 4; ++a)
#pragma unroll
            for (int b = 0; b < 2; ++b) { accf[a][b] = (f32x4){0.f, 0.f, 0.f, 0.f}; accb[a][b] = (f32x4){0.f, 0.f, 0.f, 0.f}; }
#pragma unroll
        for (int ks = 0; ks < 4; ++ks) {
            s16x8 Y[2], Xf[4], Xb[4];
#pragma unroll
            for (int nt = 0; nt < 2; ++nt) Y[nt] = tr_frag(imV, 2 * wc + nt, ks, lane);
#pragma unroll
            for (int mt = 0; mt < 4; ++mt) { Xf[mt] = tr_frag(imKf, 4 * wr + mt, ks, lane); Xb[mt] = tr_frag(imKb, 4 * wr + mt, ks, lane); }
#pragma unroll
            for (int mt = 0; mt < 4; ++mt)
#pragma unroll
                for (int nt = 0; nt < 2; ++nt) { accf[mt][nt] = MFMA16(Xf[mt], Y[nt], accf[mt][nt]); accb[mt][nt] = MFMA16(Xb[mt], Y[nt], accb[mt][nt]); }
        }
        bf16_t* stf = st + ((size_t)(ck * 8 + head) * 2) * 16384; bf16_t* stb = stf + 16384;
#pragma unroll
        for (int mt = 0; mt < 4; ++mt)
#pragma unroll
            for (int nt = 0; nt < 2; ++nt) { const int d = 64 * wr + 16 * mt + 4 * fq, e = 32 * wc + 16 * nt + fr;
                u32x2 w; w.x = pk2(accf[mt][nt][0], accf[mt][nt][1]); w.y = pk2(accf[mt][nt][2], accf[mt][nt][3]); *(u32x2*)(stf + e * 128 + d) = w;
                w.x = pk2(accb[mt][nt][0], accb[mt][nt][1]); w.y = pk2(accb[mt][nt][2], accb[mt][nt][3]); *(u32x2*)(stb + e * 128 + d) = w; }
    }
    __syncthreads();
}

struct LruP { const float* conv_w; const float* conv_b; const float* ba[2]; const float* bx[2]; const float* lam[2]; };
__device__ __forceinline__ void l1_unit(LAS unsigned char* lds, const bf16_t* proj, const bf16_t* Wl, bf16_t* lbuf, float* agg, const LruP& P, int ck, int smask, int tid_in) {
    const int r0 = ck * 128, pos0 = r0 & smask, S = smask + 1;
    u32x4 un[7];
    {   int tid = tid_in; asm volatile("" : "+v"(tid)); const int ch = tid & 15, tg = tid >> 4;
#pragma unroll
        for (int j = 0; j < 7; ++j) { const int t = 4 * tg - 2 + j, pos = pos0 + t; un[j] = (u32x4){0u, 0u, 0u, 0u};
            if (pos >= 0 && pos < S) un[j] = *(const u32x4*)(proj + (size_t)(r0 + t) * INW + 4096 + ch * 8); } }
#pragma unroll 1
    for (int g = 0; g < 8; ++g) {
        int tid = tid_in; asm volatile("" : "+v"(tid)); int lane = tid & 63, fr = lane & 15, fq = lane >> 4; const int wid = __builtin_amdgcn_readfirstlane(tid >> 6);
        LAS unsigned char* imU = lds + (g & 1) * 32768; LAS unsigned char* sY = lds + 65536 + wid * 8448; LAS unsigned char* sF = sY + 4224; LAS unsigned char* sB = sF + 2112;
        const int cb = 16 * wid + fr, c = g * 128 + cb;
        s16x8 Bw[2][4];
#pragma unroll
        for (int gt = 0; gt < 2; ++gt)
#pragma unroll
            for (int ks = 0; ks < 4; ++ks) Bw[gt][ks] = *(const s16x8*)(Wl + ((size_t)((g * 4 + gt) * 128 + cb)) * 128 + 32 * ks + 8 * fq);
        {   const int ch = tid & 15, tg = tid >> 4, c0 = g * 128 + ch * 8; u32x4 u[7];
#pragma unroll
            for (int j = 0; j < 7; ++j) u[j] = un[j];
            const f32x4 b0 = *(const f32x4*)(P.conv_b + c0), b1 = *(const f32x4*)(P.conv_b + c0 + 4);
            f32x4 a0[4], a1[4];
#pragma unroll
            for (int o = 0; o < 4; ++o) { a0[o] = b0; a1[o] = b1; }
#pragma unroll
            for (int k = 0; k < 4; ++k) { const f32x4 w0 = *(const f32x4*)(P.conv_w + k * 1024 + c0), w1 = *(const f32x4*)(P.conv_w + k * 1024 + c0 + 4);
#pragma unroll
                for (int o = 0; o < 4; ++o) { const u32x4 v = u[o + k];
                    a0[o] += (f32x4){bflo(v.x), bfhi(v.x), bflo(v.y), bfhi(v.y)} * w0; a1[o] += (f32x4){bflo(v.z), bfhi(v.z), bflo(v.w), bfhi(v.w)} * w1; } }
#pragma unroll
            for (int o = 0; o < 4; ++o) { u32x4 w; w.x = pk2(a0[o][0], a0[o][1]); w.y = pk2(a0[o][2], a0[o][3]); w.z = pk2(a1[o][0], a1[o][1]); w.w = pk2(a1[o][2], a1[o][3]);
                *(LAS u32x4*)(imU + off_b((unsigned)(4 * tg + o), (unsigned)ch)) = w; } }
        __syncthreads();
        if (g < 7) { const int ch = tid & 15, tg = tid >> 4;
#pragma unroll
            for (int j = 0; j < 7; ++j) { const int t = 4 * tg - 2 + j, pos = pos0 + t; un[j] = (u32x4){0u, 0u, 0u, 0u};
                if (pos >= 0 && pos < S) un[j] = *(const u32x4*)(proj + (size_t)(r0 + t) * INW + 4096 + (g + 1) * 128 + ch * 8); } }
#pragma unroll
        for (int dir = 0; dir < 2; ++dir) {
            { int t2 = tid; asm volatile("" : "+v"(t2)); lane = t2 & 63; fr = lane & 15; fq = lane >> 4; }
            f32x4 acc[8][2];
#pragma unroll
            for (int m = 0; m < 8; ++m) { acc[m][0] = (f32x4){0.f, 0.f, 0.f, 0.f}; acc[m][1] = (f32x4){0.f, 0.f, 0.f, 0.f}; }
#pragma unroll
            for (int ks = 0; ks < 4; ++ks) {
#pragma unroll
                for (int m = 0; m < 8; ++m) { const s16x8 Af = *(LAS s16x8*)(imU + off_b((unsigned)(32 * (fr >> 2) + 4 * m + (fr & 3)), (unsigned)(4 * ks + fq)));
                    acc[m][0] = MFMA16(Af, Bw[0][ks], acc[m][0]); acc[m][1] = MFMA16(Af, Bw[1][ks], acc[m][1]); } }
            if (dir == 0) {
#pragma unroll
                for (int gt = 0; gt < 2; ++gt)
#pragma unroll
                    for (int ks = 0; ks < 4; ++ks) Bw[gt][ks] = *(const s16x8*)(Wl + ((size_t)((g * 4 + 2 + gt) * 128 + cb)) * 128 + 32 * ks + 8 * fq); }
            const float nba = -1.44269504089f * P.ba[dir][c], nbx = -1.44269504089f * P.bx[dir][c], lam = P.lam[dir][c];
            const float c8sp = -8.0f * 1.44269504089f * log1pf(expf(-lam));
            float Pseg = 1.f, Eseg = 0.f;
#pragma unroll
            for (int mm = 0; mm < 8; ++mm) { const int m = dir ? 7 - mm : mm;
                const unsigned q = ((unsigned)lane & 15u) >> 2, p = (unsigned)lane & 3u;
                const s16x4 t = __builtin_amdgcn_ds_read_tr16_b64_v4i16((LAS s16x4*)(imU + off_b(32u * fq + 4u * m + q, 2u * wid + (p >> 1)) + 8u * (p & 1u)));
#pragma unroll
                for (int rr = 0; rr < 4; ++rr) { const int r = dir ? 3 - rr : rr;
                    const float ucv = __uint_as_float(((unsigned)(unsigned short)t[r]) << 16);
                    const float rg = __builtin_amdgcn_rcpf(1.0f + fexp2(fmaf(acc[m][0][r], -1.44269504089f, nba))), ig = __builtin_amdgcn_rcpf(1.0f + fexp2(fmaf(acc[m][1][r], -1.44269504089f, nbx)));
                    const float a = fexp2(c8sp * rg), b = __builtin_amdgcn_sqrtf(fmaxf(fmaf(-a, a, 1.0f), 0.0f)) * (ig * ucv);
                    acc[m][0][r] = a; acc[m][1][r] = b; Eseg = fmaf(a, Eseg, b); Pseg *= a; } }
            float Ps[4], Es[4];
#pragma unroll
            for (int s = 0; s < 4; ++s) { Ps[s] = __shfl(Pseg, fr + 16 * s); Es[s] = __shfl(Eseg, fr + 16 * s); }
            float Apre = 1.f, hpre = 0.f, Pall = 1.f, Eall = 0.f;
#pragma unroll
            for (int ss = 0; ss < 4; ++ss) { const int s = dir ? 3 - ss : ss;
                const bool before = dir ? (s > fq) : (s < fq);
                if (before) { hpre = fmaf(hpre, Ps[s], Es[s]); Apre *= Ps[s]; }
                Eall = fmaf(Eall, Ps[s], Es[s]); Pall *= Ps[s]; }
            if (fq == 0) { agg[((size_t)(ck * 2 + dir) * 2 + 0) * 1024 + c] = Pall; agg[((size_t)(ck * 2 + dir) * 2 + 1) * 1024 + c] = Eall; }
            LAS unsigned char* sA = (dir ? sB : sF) + fq * 528 + fr;
            LAS unsigned char* sy = sY + fq * 1056 + fr * 2;
            float Acum = Apre, h = hpre;
#pragma unroll
            for (int mm = 0; mm < 8; ++mm) { const int m = dir ? 7 - mm : mm;
#pragma unroll
                for (int rr = 0; rr < 4; ++rr) { const int r = dir ? 3 - rr : rr; const int kk = 4 * m + r;
                    Acum *= acc[m][0][r]; h = fmaf(acc[m][0][r], h, acc[m][1][r]);
                    *(LAS unsigned char*)(sA + kk * 16) = (unsigned char)(unsigned)(Acum * 255.0f + 0.5f);
                    float yv = h;
                    if (dir == 1) yv += __uint_as_float(((unsigned)*(LAS unsigned short*)(sy + kk * 32)) << 16);
                    *(LAS unsigned short*)(sy + kk * 32) = (unsigned short)(pk2(yv, 0.f) & 0xffffu); } }
        }
        asm volatile("s_waitcnt lgkmcnt(0)" ::: "memory");
        {
            const int p = lane & 3; unsigned char* l8 = (unsigned char*)lbuf;
#pragma unroll
            for (int it = 0; it < 8; ++it) { const int tok = 16 * it + (lane >> 2), fb = tok >> 5, kk = tok & 31;
                const unsigned so = p < 2 ? (unsigned)(fb * 1056 + kk * 32 + 16 * p) : (unsigned)((p == 2 ? 4224 : 6336) + fb * 528 + kk * 16);
                *(u32x4*)(l8 + (((size_t)(r0 + tok) * 64 + (g * 8 + wid)) * 64 + 16 * p)) = *(LAS u32x4*)(sY + so); } }
        asm volatile("" ::: "memory");
    }
    __syncthreads();
}

__device__ __forceinline__ void b2_item(bf16_t* st, int b, int head, int dir, int slice, int Nc, int tid) {
    const float gC = fexp2(head_l2g(head) * 128.0f);
    bf16_t* base = st + ((size_t)((b * Nc) * 8 + head) * 2 + dir) * 16384 + slice * 4096 + tid * 8;
    const size_t cstride = (size_t)8 * 2 * 16384;
    float s[8];
#pragma unroll
    for (int j = 0; j < 8; ++j) s[j] = 0.f;
    for (int n0 = 0; n0 < Nc; n0 += 16) {
        u32x4 v[16];
#pragma unroll
        for (int u = 0; u < 16; ++u) { const int n = dir ? Nc - 1 - (n0 + u) : n0 + u; v[u] = *(const u32x4*)(base + (size_t)n * cstride); }
#pragma unroll
        for (int u = 0; u < 16; ++u) { const int n = dir ? Nc - 1 - (n0 + u) : n0 + u;
            u32x4 o; o.x = pk2(s[0], s[1]); o.y = pk2(s[2], s[3]); o.z = pk2(s[4], s[5]); o.w = pk2(s[6], s[7]); *(u32x4*)(base + (size_t)n * cstride) = o;
            s[0] = fmaf(s[0], gC, bflo(v[u].x)); s[1] = fmaf(s[1], gC, bfhi(v[u].x)); s[2] = fmaf(s[2], gC, bflo(v[u].y)); s[3] = fmaf(s[3], gC, bfhi(v[u].y));
            s[4] = fmaf(s[4], gC, bflo(v[u].z)); s[5] = fmaf(s[5], gC, bfhi(v[u].z)); s[6] = fmaf(s[6], gC, bflo(v[u].w)); s[7] = fmaf(s[7], gC, bfhi(v[u].w)); }
    }
}
__device__ __forceinline__ void phase_scans(bf16_t* st, const float* agg, float* carry, int nseq, int Nc, int tid) {
    const int nitems = nseq * 64;
    for (int it = blockIdx.x; it < nitems; it += gridDim.x) { const int slice = it & 3, dir = (it >> 2) & 1, head = (it >> 3) & 7, b = it >> 6; b2_item(st, b, head, dir, slice, Nc, tid); }
    const int nthr = nseq * 2048;
    for (int i = blockIdx.x * NTHR + tid; i < nthr; i += gridDim.x * NTHR) { const int c = i & 1023, dir = (i >> 10) & 1, b = i >> 11; float H = 0.f;
        for (int n0 = 0; n0 < Nc; n0 += 8) { float Pv[8], Ev[8];
#pragma unroll
            for (int u = 0; u < 8; ++u) { const int n = dir ? Nc - 1 - (n0 + u) : n0 + u, ck = b * Nc + n;
                Pv[u] = agg[((size_t)(ck * 2 + dir) * 2 + 0) * 1024 + c]; Ev[u] = agg[((size_t)(ck * 2 + dir) * 2 + 1) * 1024 + c]; }
#pragma unroll
            for (int u = 0; u < 8; ++u) { const int n = dir ? Nc - 1 - (n0 + u) : n0 + u, ck = b * Nc + n;
                carry[(size_t)(ck * 2 + dir) * 1024 + c] = H; H = fmaf(H, Pv[u], Ev[u]); } } }
}
__device__ __forceinline__ void b3_chunk(LAS unsigned char* lds, const bf16_t* proj, const bf16_t* st, bf16_t* mix, const float* rnorm, int ck, int tid_in) {
    LAS unsigned char* imK = lds; LAS unsigned char* imV = lds + 32768; LAS unsigned char* imSf = lds + 65536; LAS unsigned char* imSb = lds + 98304;
    u32x4 pf[16]; s16x8 Yqn[4];
    {   int tid = tid_in; asm volatile("" : "+v"(tid)); const int lane = tid & 63, wid = __builtin_amdgcn_readfirstlane(tid >> 6);
        if (tid < 256) *(LAS f32x4*)(lds + LDS_WORK + 1024 + tid * 16) = *(const f32x4*)(rnorm + tid * 4);
#pragma unroll
        for (int ks = 0; ks < 4; ++ks) Yqn[ks] = *(const s16x8*)(proj + (size_t)(ck * 128 + 16 * wid + (lane & 15)) * INW + 32 * ks + 8 * (lane >> 4));
        const bf16_t* Kg = proj + (size_t)(ck * 128) * INW + 1024; const bf16_t* sg = st + ((size_t)(ck * 8) * 2) * 16384;
#pragma unroll
        for (int i = 0; i < 4; ++i) { const int q = tid + 512 * i, row = q >> 4, ch = q & 15;
            pf[i] = *(const u32x4*)(Kg + (size_t)row * INW + ch * 8); pf[4 + i] = *(const u32x4*)(Kg + 1024 + (size_t)row * INW + ch * 8);
            pf[8 + i] = *(const u32x4*)(sg + row * 128 + ch * 8); pf[12 + i] = *(const u32x4*)(sg + 16384 + row * 128 + ch * 8); } }
#pragma unroll 1
    for (int head = 0; head < 8; ++head) {
        int tid = tid_in; asm volatile("" : "+v"(tid)); const int lane = tid & 63, wid = __builtin_amdgcn_readfirstlane(tid >> 6), fr = lane & 15, fq = lane >> 4;
        const float l2g = head_l2g(head);
        const bf16_t* Qg = proj + (size_t)(ck * 128) * INW + head * 128;
        __syncthreads();
#pragma unroll
        for (int i = 0; i < 4; ++i) { const int q = tid + 512 * i, row = q >> 4, ch = q & 15; const unsigned off = off_b(row, ch);
            *(LAS u32x4*)(imK + off) = pf[i]; *(LAS u32x4*)(imV + off) = pf[4 + i]; *(LAS u32x4*)(imSf + off) = pf[8 + i]; *(LAS u32x4*)(imSb + off) = pf[12 + i]; }
        const int i_tok = 16 * wid + fr;
        s16x8 Yq[4];
#pragma unroll
        for (int ks = 0; ks < 4; ++ks) Yq[ks] = Yqn[ks];
        __syncthreads();
        const bf16_t* Gg = Qg + 3072 + (size_t)i_tok * INW;
        u32x2 gv[8];
#pragma unroll
        for (int et = 0; et < 8; ++et) gv[et] = *(const u32x2*)(Gg + 16 * et + 4 * fq);
        if (head < 7) {
            const bf16_t* Kg = proj + (size_t)(ck * 128) * INW + 1024 + (head + 1) * 128; const bf16_t* sg = st + ((size_t)(ck * 8 + head + 1) * 2) * 16384;
#pragma unroll
            for (int ks = 0; ks < 4; ++ks) Yqn[ks] = *(const s16x8*)(Qg + 128 + (size_t)i_tok * INW + 32 * ks + 8 * fq);
#pragma unroll
            for (int i = 0; i < 4; ++i) { const int q = tid + 512 * i, row = q >> 4, ch = q & 15;
                pf[i] = *(const u32x4*)(Kg + (size_t)row * INW + ch * 8); pf[4 + i] = *(const u32x4*)(Kg + 1024 + (size_t)row * INW + ch * 8);
                pf[8 + i] = *(const u32x4*)(sg + row * 128 + ch * 8); pf[12 + i] = *(const u32x4*)(sg + 16384 + row * 128 + ch * 8); } }
        s16x8 Yp[4];
        {   f32x4 accP[8];
#pragma unroll
            for (int jt = 0; jt < 8; ++jt) accP[jt] = (f32x4){0.f, 0.f, 0.f, 0.f};
#pragma unroll
            for (int ks = 0; ks < 4; ++ks)
#pragma unroll
                for (int jt = 0; jt < 8; ++jt) { const unsigned j = 32u * (jt >> 1) + 8u * ((unsigned)fr >> 2) + 4u * (jt & 1) + ((unsigned)fr & 3u);
                    accP[jt] = MFMA16(*(LAS s16x8*)(imK + off_b(j, (unsigned)(4 * ks + fq))), Yq[ks], accP[jt]); }
#pragma unroll
            for (int ks = 0; ks < 4; ++ks) { float w[8];
#pragma unroll
                for (int t = 0; t < 2; ++t)
#pragma unroll
                    for (int r = 0; r < 4; ++r) { const int j = 32 * ks + 8 * fq + 4 * t + r, dd = i_tok - j; w[4 * t + r] = accP[2 * ks + t][r] * fexp2(l2g * (float)(dd < 0 ? -dd : dd)); }
                u32x4 o; o.x = pk2(w[0], w[1]); o.y = pk2(w[2], w[3]); o.z = pk2(w[4], w[5]); o.w = pk2(w[6], w[7]);
                Yp[ks] = __builtin_bit_cast(s16x8, o); }
        }
        f32x4 accI[8], accF[8];
#pragma unroll
        for (int et = 0; et < 8; ++et) { accI[et] = (f32x4){0.f, 0.f, 0.f, 0.f}; accF[et] = (f32x4){0.f, 0.f, 0.f, 0.f}; }
#pragma unroll
        for (int ks = 0; ks < 4; ++ks)
#pragma unroll
            for (int et = 0; et < 8; ++et) { accI[et] = MFMA16(tr_frag(imV, et, ks, lane), Yp[ks], accI[et]); accF[et] = MFMA16(row_frag(imSf, et, ks, lane), Yq[ks], accF[et]); }
        const float qf = fexp2(l2g * (float)(i_tok + 1)), qb = fexp2(l2g * (float)(128 - i_tok));
#pragma unroll
        for (int et = 0; et < 8; ++et) { accI[et] = accI[et] + accF[et] * qf; accF[et] = (f32x4){0.f, 0.f, 0.f, 0.f}; }
#pragma unroll
        for (int ks = 0; ks < 4; ++ks)
#pragma unroll
            for (int et = 0; et < 8; ++et) accF[et] = MFMA16(row_frag(imSb, et, ks, lane), Yq[ks], accF[et]);
        float ss = 0.f;
#pragma unroll
        for (int et = 0; et < 8; ++et) { accI[et] = accI[et] + accF[et] * qb; ss += (accI[et][0] * accI[et][0] + accI[et][1] * accI[et][1]) + (accI[et][2] * accI[et][2] + accI[et][3] * accI[et][3]); }
        ss += __shfl_xor(ss, 16); ss += __shfl_xor(ss, 32);
        const float sc = 1.0f / sqrtf(ss * (1.0f / 128.0f) + EPS);
        bf16_t* op = mix + (size_t)(ck * 128 + i_tok) * DM + head * 128;
#pragma unroll
        for (int et = 0; et < 8; ++et) { const int e = 16 * et + 4 * fq; const f32x4 rn = *(LAS f32x4*)(lds + LDS_WORK + 1024 + (head * 128 + e) * 4);
            const float g0 = bflo(gv[et].x), g1 = bfhi(gv[et].x), g2 = bflo(gv[et].y), g3 = bfhi(gv[et].y);
            u32x2 o; o.x = pk2(accI[et][0] * sc * rn[0] * (g0 * fsigmoid(g0)), accI[et][1] * sc * rn[1] * (g1 * fsigmoid(g1)));
            o.y = pk2(accI[et][2] * sc * rn[2] * (g2 * fsigmoid(g2)), accI[et][3] * sc * rn[3] * (g3 * fsigmoid(g3)));
            *(u32x2*)(op + e) = o; }
    }
    __syncthreads();
}
__device__ __forceinline__ float gelu_tanh(float x) { const float z = 0.7978845608028654f * (x + 0.044715f * x * x * x); const float t = 1.0f - 2.0f * __builtin_amdgcn_rcpf(1.0f + fexp2(2.885390081777927f * z)); return 0.5f * x * (1.0f + t); }
__device__ __forceinline__ void l3_rows(const bf16_t* proj, const bf16_t* lbuf, const float* carry, const float* lnorm, bf16_t* mix, int lane, int wave) {
    const int gw = blockIdx.x * NWAVES + wave, NGW = gridDim.x * NWAVES;
    const unsigned char* l8 = (const unsigned char*)lbuf;
    const int c0 = 16 * lane;
    for (int blk = gw; blk < HROWS / 16; blk += NGW) {
        const int m0 = blk * 16, ck = m0 >> 7;
        f32x4 hf[4], hb[4], ln[4];
#pragma unroll
        for (int q = 0; q < 4; ++q) { hf[q] = *(const f32x4*)(carry + (size_t)(ck * 2 + 0) * 1024 + c0 + 4 * q); hb[q] = *(const f32x4*)(carry + (size_t)(ck * 2 + 1) * 1024 + c0 + 4 * q); ln[q] = *(const f32x4*)(lnorm + c0 + 4 * q); }
        u32x4 rec[4], uy[2];
#pragma unroll
        for (int q = 0; q < 4; ++q) rec[q] = *(const u32x4*)(l8 + ((size_t)m0 * 64 + lane) * 64 + 16 * q);
        uy[0] = *(const u32x4*)(proj + (size_t)m0 * INW + 5120 + c0); uy[1] = *(const u32x4*)(proj + (size_t)m0 * INW + 5120 + c0 + 8);
#pragma unroll 1
        for (int k = 0; k < 16; ++k) { const int m = m0 + k;
            float y[16], gt[16]; float ss = 0.f;
            const float s8 = 1.0f / 255.0f;
#pragma unroll
            for (int q = 0; q < 4; ++q) {
                const unsigned yw0 = q < 2 ? (q == 0 ? rec[0].x : rec[0].z) : (q == 2 ? rec[1].x : rec[1].z), yw1 = q < 2 ? (q == 0 ? rec[0].y : rec[0].w) : (q == 2 ? rec[1].y : rec[1].w);
                const unsigned fw = q == 0 ? rec[2].x : q == 1 ? rec[2].y : q == 2 ? rec[2].z : rec[2].w, bw = q == 0 ? rec[3].x : q == 1 ? rec[3].y : q == 2 ? rec[3].z : rec[3].w;
                y[4 * q + 0] = bflo(yw0) + (float)(fw & 0xffu) * s8 * hf[q][0] + (float)(bw & 0xffu) * s8 * hb[q][0];
                y[4 * q + 1] = bfhi(yw0) + (float)((fw >> 8) & 0xffu) * s8 * hf[q][1] + (float)((bw >> 8) & 0xffu) * s8 * hb[q][1];
                y[4 * q + 2] = bflo(yw1) + (float)((fw >> 16) & 0xffu) * s8 * hf[q][2] + (float)((bw >> 16) & 0xffu) * s8 * hb[q][2];
                y[4 * q + 3] = bfhi(yw1) + (float)(fw >> 24) * s8 * hf[q][3] + (float)(bw >> 24) * s8 * hb[q][3]; }
#pragma unroll
            for (int j = 0; j < 2; ++j) { gt[8 * j + 0] = bflo(uy[j].x); gt[8 * j + 1] = bfhi(uy[j].x); gt[8 * j + 2] = bflo(uy[j].y); gt[8 * j + 3] = bfhi(uy[j].y);
                gt[8 * j + 4] = bflo(uy[j].z); gt[8 * j + 5] = bfhi(uy[j].z); gt[8 * j + 6] = bflo(uy[j].w); gt[8 * j + 7] = bfhi(uy[j].w); }
            if (k < 15) {
#pragma unroll
                for (int q = 0; q < 4; ++q) rec[q] = *(const u32x4*)(l8 + ((size_t)(m + 1) * 64 + lane) * 64 + 16 * q);
                uy[0] = *(const u32x4*)(proj + (size_t)(m + 1) * INW + 5120 + c0); uy[1] = *(const u32x4*)(proj + (size_t)(m + 1) * INW + 5120 + c0 + 8); }
#pragma unroll
            for (int q = 0; q < 16; ++q) ss += y[q] * y[q];
            const float sc = 1.0f / sqrtf(wave_sum(ss) * (1.0f / LRUW) + EPS);
            u32x4 o[2];
#pragma unroll
            for (int j = 0; j < 2; ++j) {
                o[j].x = pk2(y[8 * j + 0] * sc * ln[2 * j][0] * gelu_tanh(gt[8 * j + 0]), y[8 * j + 1] * sc * ln[2 * j][1] * gelu_tanh(gt[8 * j + 1]));
                o[j].y = pk2(y[8 * j + 2] * sc * ln[2 * j][2] * gelu_tanh(gt[8 * j + 2]), y[8 * j + 3] * sc * ln[2 * j][3] * gelu_tanh(gt[8 * j + 3]));
                o[j].z = pk2(y[8 * j + 4] * sc * ln[2 * j + 1][0] * gelu_tanh(gt[8 * j + 4]), y[8 * j + 5] * sc * ln[2 * j + 1][1] * gelu_tanh(gt[8 * j + 5]));
                o[j].w = pk2(y[8 * j + 6] * sc * ln[2 * j + 1][2] * gelu_tanh(gt[8 * j + 6]), y[8 * j + 7] * sc * ln[2 * j + 1][3] * gelu_tanh(gt[8 * j + 7])); }
            *(u32x4*)(mix + (size_t)m * DM + 1024 + c0) = o[0]; *(u32x4*)(mix + (size_t)m * DM + 1024 + c0 + 8) = o[1];
        }
    }
}
#ifndef WGM_NARROW
#define WGM_NARROW 4
#endif
__global__ void __launch_bounds__(NTHR, 2) hymba_fwd(Args A) {
    extern __shared__ __attribute__((aligned(16))) unsigned char lds_raw[];
    LAS unsigned char* lds = (LAS unsigned char*)lds_raw;
    volatile LAS unsigned* MISC = (volatile LAS unsigned*)(lds + LDS_WORK);
    unsigned char* ws = A.ws;
    const int wave0 = __builtin_amdgcn_readfirstlane((int)threadIdx.x >> 6);
    if (threadIdx.x < 64) MISC[threadIdx.x] = 0u;
    __syncthreads();
    XcdBarrier bar; bar.bar = (unsigned*)(ws + WS_CTL); bar.x = 0; bar.st = nullptr;
    if (A.use_bar) bar = xcd_barrier_post((unsigned*)(ws + WS_CTL), MISC);
#define GRID_BAR() do { if (A.use_bar) xcd_barrier(bar); else __syncthreads(); } while (0)
#define IN(k) (A.p_lo <= (k) && (k) < A.p_hi)
#define TIDS() int tid = wave0 * 64 + (int)__builtin_amdgcn_mbcnt_hi(~0u, __builtin_amdgcn_mbcnt_lo(~0u, 0u)); asm volatile("" : "+v"(tid)); const int lane = tid & 63, wave = __builtin_amdgcn_readfirstlane(tid >> 6); (void)lane; (void)wave
    float* rstat_all = (float*)(ws + WS_RSTAT);
    const float* cosT = (const float*)(ws + WS_COS); const float* sinT = (const float*)(ws + WS_SIN);
    float* agg = (float*)(ws + WS_AGG); float* carry = (float*)(ws + WS_CARRY);
    bf16_t* big = (bf16_t*)(ws + WS_BIG); bf16_t* st = (bf16_t*)(ws + WS_ST); bf16_t* lbuf = (bf16_t*)(ws + WS_LRU);

    { TIDS(); phase_convert(A, 0, lds, tid, lane, wave, 0, 25344, 7); GRID_BAR(); }
    for (int l = 0; l < DEPTH; ++l) {
        for (int h = 0; h < 2; ++h) {
            bf16_t* xb = (bf16_t*)(ws + WS_XB) + (size_t)h * HROWS * DM;
            float* rstat = rstat_all + h * HROWS;
            const int smask = h ? 8191 : 4095, nseq = h ? 4 : 8, Nc = h ? 64 : 32;
            bf16_t* mixb = (bf16_t*)(A.out + (size_t)h * HROWS * DM);
            bf16_t* fout = st;
            {
                const bool has_prev = (l > 0) || (h > 0);
                const int pl = h ? l : l - 1, ph = h ^ 1;
                bf16_t* pxb = (bf16_t*)(ws + WS_XB) + (size_t)ph * HROWS * DM; float* prs = rstat_all + ph * HROWS;
                const bool first = (blockIdx.x & 1) != 0;
                float* pxf = (pl == DEPTH - 1) ? A.out + (size_t)ph * HROWS * DM : nullptr;
                const bool cvt_dn = (h == 0 && l > 0);
                if (has_prev && first) { TIDS(); phase_residual(pxb, st, A.in[24] + pl * DM, prs, pxf, lane, wave); if (cvt_dn) phase_convert(A, l, lds, tid, lane, wave, 19456, 25088, 0); __syncthreads(); }
                {
                    pg8::Gemm g{xb, (const bf16_t*)(ws + WS_WIN), HROWS, INW, DM}; pg8::StaticOrder S; S.init(HROWS, INW, (int)gridDim.x, (int)blockIdx.x, WGM_NARROW);
                    pg8::EpiProj E{big, rstat, cosT, sinT, smask, lds};
                    pg8::gemm_phase<pg8::EpiProj, pg8::StaticOrder, true, true>(lds, g, S, E, wave0);
                }
                if (has_prev && !first) { TIDS(); phase_residual(pxb, st, A.in[24] + pl * DM, prs, pxf, lane, wave); if (cvt_dn) phase_convert(A, l, lds, tid, lane, wave, 19456, 25088, 0); }
                GRID_BAR();
            }
            {
                TIDS(); LruP P; P.conv_w = A.in[5] + l * 4 * 1024; P.conv_b = A.in[6] + l * 1024;
                P.ba[0] = A.in[8] + l * 1024; P.bx[0] = A.in[10] + l * 1024; P.lam[0] = A.in[11] + l * 1024;
                P.ba[1] = A.in[13] + l * 1024; P.bx[1] = A.in[15] + l * 1024; P.lam[1] = A.in[16] + l * 1024;
                for (int ck = blockIdx.x; ck < 256; ck += gridDim.x) {
                    l1_unit(lds, big, (const bf16_t*)(ws + WS_WLRU), lbuf, agg, P, ck, smask, tid);
                    b1_chunk(lds, big, st, ck, tid);
                }
                GRID_BAR();
            }
            { TIDS(); phase_scans(st, agg, carry, nseq, Nc, tid); GRID_BAR(); }
            {
                TIDS();
                for (int ck = blockIdx.x; ck < 256; ck += gridDim.x) b3_chunk(lds, big, st, mixb, A.in[4] + l * 1024, ck, tid);
                l3_rows(big, lbuf, carry, A.in[17] + l * 1024, mixb, lane, wave);
                GRID_BAR();
            }
            {
                pg8::Gemm g{mixb, (const bf16_t*)(ws + WS_WOUT), HROWS, DM, DM}; pg8::StaticOrder S; S.init(HROWS, DM, (int)gridDim.x, (int)blockIdx.x, WGM_NARROW);
                pg8::EpiBf16 E{big, DM};
                pg8::gemm_phase<pg8::EpiBf16, pg8::StaticOrder, true, true>(lds, g, S, E, wave0);
                GRID_BAR();
            }
            {
                TIDS();
                phase_residual(xb, big, A.in[19] + l * DM, rstat, nullptr, lane, wave);
                GRID_BAR();
            }
            {
                pg8::Gemm g{xb, (const bf16_t*)(ws + WS_WGU), HROWS, 2 * DFF, DM}; pg8::StaticOrder S; S.init(HROWS, 2 * DFF, (int)gridDim.x, (int)blockIdx.x, WGM_NARROW);
                pg8::EpiSwiGLU E{big, rstat, lds};
                const bool cvt = (h == 1 && l + 1 < DEPTH), first = (blockIdx.x & 1) != 0;
                if (cvt && first) { TIDS(); phase_convert(A, l + 1, lds, tid, lane, wave, 0, 8192, 0); phase_convert(A, l + 1, lds, tid, lane, wave, 25088, 25344, 0); __syncthreads(); }
                pg8::gemm_phase<pg8::EpiSwiGLU, pg8::StaticOrder, true, true>(lds, g, S, E, wave0);
                if (cvt && !first) { TIDS(); phase_convert(A, l + 1, lds, tid, lane, wave, 0, 8192, 0); phase_convert(A, l + 1, lds, tid, lane, wave, 25088, 25344, 0); }
                GRID_BAR();
            }
            {
                pg8::Gemm g{big, (const bf16_t*)(ws + WS_WDN), HROWS, DM, DFF}; pg8::StaticOrder S; S.init(HROWS, DM, (int)gridDim.x, (int)blockIdx.x, WGM_NARROW);
                pg8::EpiBf16 E{fout, DM};
                const bool cvt = (h == 1 && l + 1 < DEPTH), first = (blockIdx.x & 1) != 0;
                if (cvt && first) { TIDS(); phase_convert(A, l + 1, lds, tid, lane, wave, 8192, 19456, 0); __syncthreads(); }
                pg8::gemm_phase<pg8::EpiBf16, pg8::StaticOrder, true, true>(lds, g, S, E, wave0);
                if (cvt && !first) { TIDS(); phase_convert(A, l + 1, lds, tid, lane, wave, 8192, 19456, 0); }
                GRID_BAR();
            }
        }
    }
    {
        TIDS(); phase_residual((bf16_t*)(ws + WS_XB) + (size_t)HROWS * DM, st, A.in[24] + (DEPTH - 1) * DM, rstat_all + HROWS, A.out + (size_t)HROWS * DM, lane, wave);
    }
#undef IN
#undef GRID_BAR
}

extern "C" void kernel_launch(void* const* d_in, const int* in_sizes, int n_in, void* d_out, int out_size, void* d_ws, size_t ws_size, hipStream_t stream) {
    static int grid = 0;
    if (grid == 0) {
        if (n_in != 25 || ws_size < WS_END || out_size != 2 * HROWS * DM) { fprintf(stderr, "kernel_launch: unexpected shapes (n_in %d, out %d, ws %zu; need ws >= %zu); nothing launched\n", n_in, out_size, ws_size, (size_t)WS_END); grid = -1; return; }
        int dev = 0, cus = 0, per_cu = 0;
        if (hipGetDevice(&dev) != hipSuccess || hipDeviceGetAttribute(&cus, hipDeviceAttributeMultiprocessorCount, dev) != hipSuccess) { grid = -1; return; }
        if (hipFuncSetAttribute((const void*)hymba_fwd, hipFuncAttributeMaxDynamicSharedMemorySize, LDS_BYTES) != hipSuccess) { fprintf(stderr, "kernel_launch: hipFuncSetAttribute failed\n"); grid = -1; return; }
        if (hipOccupancyMaxActiveBlocksPerMultiprocessor(&per_cu, (const void*)hymba_fwd, NTHR, LDS_BYTES) != hipSuccess || per_cu < 1) { fprintf(stderr, "kernel_launch: occupancy query reports %d blocks per CU\n", per_cu); (void)hipGetLastError(); grid = -1; return; }
        grid = cus;
    }
    if (grid < 0) return;
    (void)hipMemsetAsync((char*)d_ws + WS_CTL, 0, CTL_ZERO_BYTES, stream);
    Args a{};
    for (int i = 0; i < 25; ++i) a.in[i] = (const float*)d_in[i];
    a.out = (float*)d_out; a.ws = (unsigned char*)d_ws; a.pad = 0;
#if MK_ONE_LAUNCH
    a.l_lo = 0; a.l_hi = DEPTH; a.h_lo = 0; a.h_hi = 2; a.p_lo = 0; a.p_hi = NPH; a.use_bar = 1;
    hipLaunchKernelGGL(hymba_fwd, dim3(grid), dim3(NTHR), LDS_BYTES, stream, a);
#else
    a.use_bar = 0;
    for (int l = 0; l < DEPTH; ++l) for (int h = 0; h < 2; ++h) for (int p = (h == 0 ? 0 : 1); p < NPH; ++p) {
        a.l_lo = l; a.l_hi = l + 1; a.h_lo = h; a.h_hi = h + 1; a.p_lo = p; a.p_hi = p + 1;
        hipLaunchKernelGGL(hymba_fwd, dim3(grid), dim3(NTHR), LDS_BYTES, stream, a);
    }
#endif
}
```

```cpp
#include <hip/hip_runtime.h>
#include <cstdio>
#include <cstdint>

#ifndef MK_ONE_LAUNCH
#define MK_ONE_LAUNCH 1
#endif

namespace pg8 {
#define PG8_LAS __attribute__((address_space(3)))
typedef unsigned short bf16_t;
typedef short bf16x8 __attribute__((ext_vector_type(8)));
typedef float f32x4 __attribute__((ext_vector_type(4)));
typedef unsigned u32x4 __attribute__((ext_vector_type(4)));
constexpr int BM = 256, BK = 64, HALF = 128, HTB = HALF * BK * 2  , STAGE_BYTES = 8 * HTB, NXCD = 8, WGM = 8;

__host__ __device__ __forceinline__ int lds_byte(int r, int c) { const int st = (r >> 4) * 2 + (c >> 5), rr = r & 15, cc = c & 31, ob = rr * 64 + cc * 2; return st * 1024 + (ob ^ (((ob >> 9) & 1) << 5)); }
__host__ __device__ __forceinline__ void stage_rc(int b, int& R, int& C) { const int st = b / 1024, sb = b % 1024, swz = sb ^ (((sb >> 9) & 1) << 5); R = (st >> 1) * 16 + swz / 64; C = (st & 1) * 32 + (swz % 64) / 2; }
__host__ __device__ __forceinline__ int perm32(int rho) { const int n = rho >> 4, i = rho & 15; return 8 * (i >> 2) + 4 * n + (i & 3); }

struct Unit { int pm, pn, slot; };
struct Gemm { const bf16_t* A; const bf16_t* Bt; int M, N, K; };

struct StaticOrder {
    int nM, nN, nwg, G, c, wgm;
    __host__ __device__ void init(int M, int N, int G_, int c_, int wgm_ = WGM) { nM = M / BM; nN = N / BM; nwg = nM * nN; G = G_; c = c_; wgm = wgm_; }
    __host__ __device__ bool next(int i, Unit& u) const {
        const long L = (long)i * G + c; if (L >= nwg) return false;
        int wgid = (int)L; { const int q = nwg / NXCD, r = nwg % NXCD, xcd = wgid % NXCD, off = wgid / NXCD; wgid = (xcd < r ? xcd * (q + 1) : r * (q + 1) + (xcd - r) * q) + off; }
        const int nig = wgm * nN, gid = wgid / nig, fm = gid * wgm, gsz = (nM - fm) < wgm ? (nM - fm) : wgm;
        u.pm = fm + ((wgid % nig) % gsz); u.pn = (wgid % nig) / gsz; return true;
    }
    __device__ __forceinline__ void a_ready(const Unit&) const {}
    __device__ __forceinline__ void done(const Unit&) const {}
};

typedef float f32x2_ __attribute__((ext_vector_type(2)));
typedef __bf16 bf16x2_ __attribute__((ext_vector_type(2)));
__device__ __forceinline__ unsigned cvt_pk_bf16(float lo, float hi) { const f32x2_ v = {lo, hi}; const bf16x2_ r = __builtin_convertvector(v, bf16x2_); return __builtin_bit_cast(unsigned, r); }

struct EpiBf16 {
    static constexpr bool PERM = true, AFTER_DRAIN = false, PRE = false;
    bf16_t* O; int ldc;
    __device__ __forceinline__ void operator()(const f32x4 (&acc)[2][2][4][2], const Unit& u, int wr, int wc, int fr, int fq) const {
        const int row0 = u.pm * BM + wr * 64 + fr, col0 = u.pn * BM + wc * 32 + 8 * fq;
#pragma unroll
        for (int ai = 0; ai < 2; ++ai)
#pragma unroll
            for (int m = 0; m < 4; ++m) { bf16_t* rowp = O + (size_t)(row0 + ai * HALF + m * 16) * ldc + col0;
#pragma unroll
                for (int bj = 0; bj < 2; ++bj) { const f32x4 v0 = acc[ai][bj][m][0], v1 = acc[ai][bj][m][1];
                    u32x4 w; w.x = cvt_pk_bf16(v0[0], v0[1]); w.y = cvt_pk_bf16(v0[2], v0[3]); w.z = cvt_pk_bf16(v1[0], v1[1]); w.w = cvt_pk_bf16(v1[2], v1[3]);
                    *(u32x4*)(rowp + bj * HALF) = w; } }
    }
};
constexpr int RS_LDS_OFF = 144384;
__device__ __forceinline__ void rs_prefetch(PG8_LAS unsigned char* lds, const float* rstat, const Unit& u, int wid, int lane) {
    if (wid < 4) __builtin_amdgcn_global_load_lds((const unsigned*)(rstat + u.pm * BM + 64 * wid + lane), (PG8_LAS unsigned*)(lds + RS_LDS_OFF + u.slot * 1024 + wid * 256), 4, 0, 0);
}
struct EpiProj {
    static constexpr bool PERM = true, AFTER_DRAIN = false, PRE = true;
    bf16_t* O; const float* rstat; const float* cosT; const float* sinT; int smask; PG8_LAS unsigned char* lds;
    __device__ __forceinline__ void prefetch(const Unit& u, int wid, int lane) const { rs_prefetch(lds, rstat, u, wid, lane); }
    __device__ __forceinline__ void operator()(const f32x4 (&acc)[2][2][4][2], const Unit& u, int wr, int wc, int fr, int fq) const {
        const int row0 = u.pm * BM + wr * 64 + fr, col0 = u.pn * BM + wc * 32 + 8 * fq;
        if (u.pn < 8) {
            const int ti = 16 * wc + 4 * fq;
            const f32x4 cd = *(const f32x4*)(cosT + 16 * 64 + ti), sd = *(const f32x4*)(sinT + 16 * 64 + ti);
#pragma unroll
            for (int ai = 0; ai < 2; ++ai) { const int pos = (row0 + ai * HALF) & smask;
                f32x4 c4 = *(const f32x4*)(cosT + pos * 64 + ti), s4 = *(const f32x4*)(sinT + pos * 64 + ti);
#pragma unroll
                for (int m = 0; m < 4; ++m) { const int row = row0 + ai * HALF + m * 16; const float rs = *(const PG8_LAS float*)(lds + RS_LDS_OFF + u.slot * 1024 + (row - u.pm * BM) * 4);
                    bf16_t* rowp = O + (size_t)row * 6144 + col0;
#pragma unroll
                    for (int bj = 0; bj < 2; ++bj) { const f32x4 x1 = acc[ai][bj][m][0], x2 = acc[ai][bj][m][1];
                        const f32x4 v0 = (x1 * c4 - x2 * s4) * rs, v1 = (x2 * c4 + x1 * s4) * rs;
                        u32x4 w; w.x = cvt_pk_bf16(v0[0], v0[1]); w.y = cvt_pk_bf16(v0[2], v0[3]); w.z = cvt_pk_bf16(v1[0], v1[1]); w.w = cvt_pk_bf16(v1[2], v1[3]);
                        *(u32x4*)(rowp + bj * HALF) = w; }
                    if (m < 3) { const f32x4 cn = c4 * cd - s4 * sd, sn = s4 * cd + c4 * sd; c4 = cn; s4 = sn; } } }
        } else {
#pragma unroll
            for (int ai = 0; ai < 2; ++ai)
#pragma unroll
                for (int m = 0; m < 4; ++m) { const int row = row0 + ai * HALF + m * 16; const float rs = *(const PG8_LAS float*)(lds + RS_LDS_OFF + u.slot * 1024 + (row - u.pm * BM) * 4);
                    bf16_t* rowp = O + (size_t)row * 6144 + col0;
#pragma unroll
                    for (int bj = 0; bj < 2; ++bj) { const f32x4 v0 = acc[ai][bj][m][0] * rs, v1 = acc[ai][bj][m][1] * rs;
                        u32x4 w; w.x = cvt_pk_bf16(v0[0], v0[1]); w.y = cvt_pk_bf16(v0[2], v0[3]); w.z = cvt_pk_bf16(v1[0], v1[1]); w.w = cvt_pk_bf16(v1[2], v1[3]);
                        *(u32x4*)(rowp + bj * HALF) = w; } }
        }
    }
};
struct EpiSwiGLU {
    static constexpr bool PERM = true, AFTER_DRAIN = false, PRE = true;
    bf16_t* O; const float* rstat; PG8_LAS unsigned char* lds;
    __device__ __forceinline__ void prefetch(const Unit& u, int wid, int lane) const { rs_prefetch(lds, rstat, u, wid, lane); }
    __device__ __forceinline__ void operator()(const f32x4 (&acc)[2][2][4][2], const Unit& u, int wr, int wc, int fr, int fq) const {
        const int row0 = u.pm * BM + wr * 64 + fr, col0 = u.pn * HALF + wc * 32 + 8 * fq;
#pragma unroll
        for (int ai = 0; ai < 2; ++ai)
#pragma unroll
            for (int m = 0; m < 4; ++m) { const int row = row0 + ai * HALF + m * 16; const float rs = *(const PG8_LAS float*)(lds + RS_LDS_OFF + u.slot * 1024 + (row - u.pm * BM) * 4);
                float o[8];
#pragma unroll
                for (int n = 0; n < 2; ++n)
#pragma unroll
                    for (int j = 0; j < 4; ++j) { const float g = acc[ai][0][m][n][j] * rs, up = acc[ai][1][m][n][j] * rs;
                        o[n * 4 + j] = g * __builtin_amdgcn_rcpf(1.0f + __builtin_amdgcn_exp2f(-1.44269504089f * g)) * up; }
                u32x4 w; w.x = cvt_pk_bf16(o[0], o[1]); w.y = cvt_pk_bf16(o[2], o[3]); w.z = cvt_pk_bf16(o[4], o[5]); w.w = cvt_pk_bf16(o[6], o[7]);
                *(u32x4*)(O + (size_t)row * 5632 + col0) = w; }
    }
};

template <class Epi, class Sched, bool ALIGN_EPI = false, bool SP2 = false>
__device__ __forceinline__ void gemm_phase(PG8_LAS unsigned char* lds, const Gemm g, const Sched& S, const Epi& E, int wave_in) {
    int tid_ = wave_in * 64 + (int)__builtin_amdgcn_mbcnt_hi(~0u, __builtin_amdgcn_mbcnt_lo(~0u, 0u)); asm volatile("" : "+v"(tid_));
    const int tid = tid_, wid = __builtin_amdgcn_readfirstlane(tid >> 6), lane = tid & 63, wr = wid >> 2, wc = wid & 3, fr = lane & 15, fq = lane >> 4;
    const int K = g.K, nt = K / BK;
    unsigned voffA[2], voffB[2];
#pragma unroll
    for (int i = 0; i < 2; ++i) { int R, C; stage_rc(tid * 16 + i * 8192, R, C); const int Rb = Epi::PERM ? ((R & ~31) + perm32(R & 31)) : R;
        voffA[i] = (unsigned)(R * K + C) * 2u; voffB[i] = (unsigned)(Rb * K + C) * 2u; }
    const size_t kstep = (size_t)(BK * 2);
    const size_t hstep = (size_t)HALF * K * 2;
    const size_t tstep = 2 * hstep;
    const unsigned ldsw = (unsigned)wid * 1024u;
    const int aoff = lds_byte(wr * 64 + fr, fq * 8), boff = lds_byte(wc * 32 + fr, fq * 8);
#define PG8_SA(b, h) (((b) * 2 + (h)) * HTB)
#define PG8_SB(b, h) ((4 + (b) * 2 + (h)) * HTB)
#define PG8_STAGE(bufoff, gbase, voff) do { _Pragma("unroll") for (int _i = 0; _i < 2; ++_i) \
        __builtin_amdgcn_global_load_lds((const unsigned*)((const char*)(gbase) + (voff)[_i]), (PG8_LAS unsigned*)(lds + (bufoff) + ldsw + _i * 8192), 16, 0, 0); } while (0)
#define PG8_LDA(dst, b, h) do { _Pragma("unroll") for (int m = 0; m < 4; ++m) _Pragma("unroll") for (int k = 0; k < 2; ++k) dst[m][k] = *(const PG8_LAS bf16x8*)(lds + PG8_SA(b, h) + aoff + m * 2048 + k * 1024); } while (0)
#define PG8_LDB(dst, b, h) do { _Pragma("unroll") for (int n = 0; n < 2; ++n) _Pragma("unroll") for (int k = 0; k < 2; ++k) dst[n][k] = *(const PG8_LAS bf16x8*)(lds + PG8_SB(b, h) + boff + n * 2048 + k * 1024); } while (0)
#define PG8_MMA(ai, bj, At, Bt) do { __builtin_amdgcn_s_setprio(1); _Pragma("unroll") for (int m = 0; m < 4; ++m) _Pragma("unroll") for (int n = 0; n < 2; ++n) _Pragma("unroll") for (int k = 0; k < 2; ++k) \
        acc[ai][bj][m][n] = __builtin_amdgcn_mfma_f32_16x16x32_bf16(Bt[n][k], At[m][k], acc[ai][bj][m][n], 0, 0, 0); __builtin_amdgcn_s_setprio(0); } while (0)
#define PG8_WAIT_V(n) asm volatile("s_waitcnt vmcnt(" #n ")" ::: "memory")
#define PG8_WAIT_L(n) asm volatile("s_waitcnt lgkmcnt(" #n ")" ::: "memory")
#define PG8_BAR __builtin_amdgcn_s_barrier()
#define PG8_SCHED __builtin_amdgcn_sched_barrier(0)
    Unit cur, nxt; int ui = 0;
    if (!S.next(0, cur)) return;
    cur.slot = 0; nxt.slot = 1;
    if constexpr (Epi::PRE) E.prefetch(cur, wid, lane);
    f32x4 acc[2][2][4][2];
#pragma unroll
    for (int a = 0; a < 2; ++a)
#pragma unroll
        for (int b = 0; b < 2; ++b)
#pragma unroll
            for (int m = 0; m < 4; ++m)
#pragma unroll
                for (int n = 0; n < 2; ++n) acc[a][b][m][n] = (f32x4){0.f, 0.f, 0.f, 0.f};
    bf16x8 At[4][2], B0[2][2], B1[2][2];
    const char* cA = (const char*)g.A + (size_t)cur.pm * tstep; const char* cB = (const char*)g.Bt + (size_t)cur.pn * tstep;
    S.a_ready(cur);
    if constexpr (SP2) {
        PG8_STAGE(PG8_SB(0, 0), cB, voffB); PG8_STAGE(PG8_SB(0, 1), cB + hstep, voffB); PG8_STAGE(PG8_SA(0, 0), cA, voffA); PG8_STAGE(PG8_SA(0, 1), cA + hstep, voffA);
        if (wr == 1) PG8_BAR;
        PG8_WAIT_V(2); PG8_BAR;
        PG8_STAGE(PG8_SB(1, 0), cB + kstep, voffB); PG8_STAGE(PG8_SA(1, 0), cA + kstep, voffA); PG8_STAGE(PG8_SB(1, 1), cB + hstep + kstep, voffB);
        PG8_WAIT_V(6); PG8_BAR;
    } else {
        PG8_STAGE(PG8_SB(0, 0), cB, voffB); PG8_STAGE(PG8_SA(0, 0), cA, voffA); PG8_STAGE(PG8_SB(0, 1), cB + hstep, voffB); PG8_STAGE(PG8_SA(0, 1), cA + hstep, voffA);
        if (wr == 1) PG8_BAR;
        PG8_WAIT_V(4); PG8_BAR;
        PG8_STAGE(PG8_SB(1, 0), cB + kstep, voffB); PG8_STAGE(PG8_SA(1, 0), cA + kstep, voffA); PG8_STAGE(PG8_SB(1, 1), cB + hstep + kstep, voffB);
        PG8_WAIT_V(6); PG8_BAR;
    }
    for (;;) {
        const bool has_next = S.next(ui + 1, nxt);
        const char* nA = has_next ? (const char*)g.A + (size_t)nxt.pm * tstep : cA; const char* nB = has_next ? (const char*)g.Bt + (size_t)nxt.pn * tstep : cB;
        for (int t = 0; t < nt; t += 2) {
            const bool last = (t == nt - 2);
            const char* a1 = cA + (size_t)(t + 1) * kstep;
            const char* a2 = last ? nA : cA + (size_t)(t + 2) * kstep; const char* b2 = last ? nB : cB + (size_t)(t + 2) * kstep;
            const char* a3 = a2 + kstep; const char* b3 = b2 + kstep;
            if (last && has_next) S.a_ready(nxt);
            if constexpr (SP2) {
            PG8_LDB(B0, 0, 0); PG8_LDB(B1, 0, 1); PG8_SCHED; PG8_LDA(At, 0, 0); PG8_STAGE(PG8_SA(1, 1), a1 + hstep, voffA);
            PG8_WAIT_V(8); PG8_WAIT_L(0); PG8_BAR; PG8_MMA(0, 0, At, B0); PG8_MMA(0, 1, At, B1); PG8_BAR; PG8_SCHED;
            PG8_LDA(At, 0, 1); PG8_STAGE(PG8_SB(0, 0), b2, voffB); PG8_STAGE(PG8_SB(0, 1), b2 + hstep, voffB); PG8_STAGE(PG8_SA(0, 0), a2, voffA);
            PG8_WAIT_V(8); PG8_WAIT_L(0); PG8_BAR; PG8_MMA(1, 0, At, B0); PG8_MMA(1, 1, At, B1); PG8_BAR; PG8_SCHED;
            PG8_LDB(B0, 1, 0); PG8_LDB(B1, 1, 1); PG8_SCHED; PG8_LDA(At, 1, 0); PG8_STAGE(PG8_SA(0, 1), a2 + hstep, voffA);
            PG8_WAIT_V(8); PG8_WAIT_L(0); PG8_BAR; PG8_MMA(0, 0, At, B0); PG8_MMA(0, 1, At, B1); PG8_BAR; PG8_SCHED;
            PG8_LDA(At, 1, 1); PG8_STAGE(PG8_SB(1, 0), b3, voffB); PG8_STAGE(PG8_SB(1, 1), b3 + hstep, voffB); PG8_STAGE(PG8_SA(1, 0), a3, voffA);
            PG8_WAIT_V(8); PG8_WAIT_L(0); PG8_BAR; PG8_MMA(1, 0, At, B0); PG8_MMA(1, 1, At, B1); PG8_BAR; PG8_SCHED;
            } else {
            PG8_LDB(B0, 0, 0); PG8_SCHED; PG8_LDA(At, 0, 0); PG8_STAGE(PG8_SA(1, 1), a1 + hstep, voffA);
            PG8_WAIT_L(8); PG8_BAR; PG8_WAIT_L(0); PG8_MMA(0, 0, At, B0); PG8_BAR; PG8_SCHED;
            PG8_LDB(B1, 0, 1); PG8_STAGE(PG8_SB(0, 0), b2, voffB);
            PG8_BAR; PG8_WAIT_L(0); PG8_MMA(0, 1, At, B1); PG8_BAR;
            PG8_LDA(At, 0, 1); PG8_STAGE(PG8_SA(0, 0), a2, voffA);
            PG8_BAR; PG8_WAIT_L(0); PG8_MMA(1, 0, At, B0); PG8_BAR; PG8_SCHED;
            PG8_STAGE(PG8_SB(0, 1), b2 + hstep, voffB);
            PG8_WAIT_V(6); PG8_BAR; PG8_MMA(1, 1, At, B1); PG8_BAR;
            PG8_LDB(B0, 1, 0); PG8_SCHED; PG8_LDA(At, 1, 0); PG8_STAGE(PG8_SA(0, 1), a2 + hstep, voffA);
            PG8_WAIT_L(8); PG8_BAR; PG8_WAIT_L(0); PG8_MMA(0, 0, At, B0); PG8_BAR; PG8_SCHED;
            PG8_LDB(B1, 1, 1); PG8_STAGE(PG8_SB(1, 0), b3, voffB);
            PG8_BAR; PG8_WAIT_L(0); PG8_MMA(0, 1, At, B1); PG8_BAR;
            PG8_LDA(At, 1, 1); PG8_STAGE(PG8_SA(1, 0), a3, voffA);
            PG8_BAR; PG8_WAIT_L(0); PG8_MMA(1, 0, At, B0); PG8_BAR; PG8_SCHED;
            PG8_STAGE(PG8_SB(1, 1), b3 + hstep, voffB);
            PG8_WAIT_V(6); PG8_BAR; PG8_MMA(1, 1, At, B1); PG8_BAR;
            }
        }
        if constexpr (ALIGN_EPI) { if (wr == 0) PG8_BAR; }
        if constexpr (!Epi::AFTER_DRAIN) { E(acc, cur, wr, wc, fr, fq); S.done(cur); }
        if constexpr (Epi::PRE) { nxt.slot = cur.slot ^ 1; if (has_next) E.prefetch(nxt, wid, lane); }
        if (!has_next) break;
#pragma unroll
        for (int a = 0; a < 2; ++a)
#pragma unroll
            for (int b = 0; b < 2; ++b)
#pragma unroll
                for (int m = 0; m < 4; ++m)
#pragma unroll
                    for (int n = 0; n < 2; ++n) acc[a][b][m][n] = (f32x4){0.f, 0.f, 0.f, 0.f};
        cur = nxt; cA = nA; cB = nB; ++ui;
        if constexpr (ALIGN_EPI) { if (wr == 1) PG8_BAR; }
    }
    PG8_WAIT_V(0);
    if constexpr (!ALIGN_EPI) { if (wr == 0) PG8_BAR; }
    PG8_BAR;
    if constexpr (Epi::AFTER_DRAIN) { E.fused(acc, cur, wr, wc, fr, fq, lds, wid, lane); S.done(cur); }
#undef PG8_SA
#undef PG8_SB
#undef PG8_STAGE
#undef PG8_LDA
#undef PG8_LDB
#undef PG8_MMA
#undef PG8_WAIT_V
#undef PG8_WAIT_L
#undef PG8_BAR
#undef PG8_SCHED
}
}


#define GAS __attribute__((address_space(1)))
#define LAS __attribute__((address_space(3)))
typedef unsigned short bf16_t;
typedef float f32x4 __attribute__((ext_vector_type(4)));
typedef short s16x4 __attribute__((ext_vector_type(4)));
typedef short s16x8 __attribute__((ext_vector_type(8)));
typedef unsigned u32x4 __attribute__((ext_vector_type(4)));
typedef unsigned u32x2 __attribute__((ext_vector_type(2)));

constexpr int NWAVES = 8, NTHR = 512;
constexpr int DM = 2048, DEPTH = 4, HROWS = 32768, INW = 6144, DFF = 5632, LRUW = 1024;
constexpr float EPS = 1e-6f;
constexpr int NPH = 10;

constexpr size_t MiB = 1u << 20;
constexpr size_t WS_CTL = 0, CTL_ZERO_BYTES = 64 * 1024;
constexpr size_t WS_RSTAT = 1 * MiB;
constexpr size_t WS_COS = 2 * MiB, WS_SIN = 4 * MiB;
constexpr size_t WS_AGG = 6 * MiB;
constexpr size_t WS_CARRY = 10 * MiB;
constexpr size_t WS_WIN = 16 * MiB;
constexpr size_t WS_WOUT = 40 * MiB;
constexpr size_t WS_WGU = 48 * MiB;
constexpr size_t WS_WDN = 92 * MiB;
constexpr size_t WS_WLRU = 114 * MiB;
constexpr size_t WS_XB = 116 * MiB;
constexpr size_t WS_BIG = 372 * MiB;
constexpr size_t WS_ST = 756 * MiB;
constexpr size_t WS_LRU = 884 * MiB;
constexpr size_t WS_END = 1076 * MiB;
constexpr int LDS_WORK = 139264, LDS_BYTES = LDS_WORK + 1024 + 4096 + 2048;
static_assert(LDS_WORK + 1024 + 4096 == pg8::RS_LDS_OFF, "row-statistic slots");

#define LDS_WAIT() asm volatile("s_waitcnt lgkmcnt(0)" ::: "memory")

__device__ __forceinline__ unsigned pk2(float lo, float hi) { return pg8::cvt_pk_bf16(lo, hi); }
__device__ __forceinline__ float bflo(unsigned w) { return __uint_as_float(w << 16); }
__device__ __forceinline__ float bfhi(unsigned w) { return __uint_as_float(w & 0xffff0000u); }
__device__ __forceinline__ float wave_sum(float v) {
#pragma unroll
    for (int o = 1; o < 64; o <<= 1) v += __shfl_xor(v, o);
    return v;
}
__device__ __forceinline__ float fexp2(float x) { return __builtin_amdgcn_exp2f(x); }
__device__ __forceinline__ float fsigmoid(float x) { return __builtin_amdgcn_rcpf(1.0f + fexp2(-1.44269504089f * x)); }

__device__ __forceinline__ unsigned off_b(unsigned row, unsigned ch) { return 256u * row + 16u * (ch ^ (((row & 3u) << 2) | ((row >> 2) & 3u))); }
__device__ __forceinline__ s16x8 row_frag(LAS unsigned char* img, int rb, int ks, int lane) { return *(LAS s16x8*)(img + off_b((unsigned)((lane & 15) + 16 * rb), (unsigned)(4 * ks + (lane >> 4)))); }
__device__ __forceinline__ s16x8 tr_frag(LAS unsigned char* img, int c, int ks, int lane) {
    const unsigned g = (unsigned)lane >> 4, q = ((unsigned)lane & 15u) >> 2, p = (unsigned)lane & 3u, row = 32u * ks + 8u * g + q, ch = 2u * c + (p >> 1);
    const s16x4 lo = __builtin_amdgcn_ds_read_tr16_b64_v4i16((LAS s16x4*)(img + off_b(row, ch) + 8u * (p & 1u)));
    const s16x4 hi = __builtin_amdgcn_ds_read_tr16_b64_v4i16((LAS s16x4*)(img + off_b(row + 4u, ch) + 8u * (p & 1u)));
    return __builtin_shufflevector(lo, hi, 0, 1, 2, 3, 4, 5, 6, 7);
}
#define MFMA16(a, b, c) __builtin_amdgcn_mfma_f32_16x16x32_bf16((a), (b), (c), 0, 0, 0)

#define XB_TMO      128
#define XB_XCNT(j)  (256  + 64 * (j))
#define XB_XSUB(j)  (1280 + 64 * (j))
#define XB_XGEN(j)  (2304 + 64 * (j))
#define XB_TOP      3328
#define XB_TOPGEN   3392
#define XCD_BAR_WORDS 3456
#define XB_SPIN_CAP (1u << 18)

__device__ __forceinline__ unsigned xb_ld(unsigned* p)              { return __hip_atomic_load(p, __ATOMIC_RELAXED, __HIP_MEMORY_SCOPE_AGENT); }
__device__ __forceinline__ unsigned xb_add(unsigned* p, unsigned v) { return __hip_atomic_fetch_add(p, v, __ATOMIC_RELAXED, __HIP_MEMORY_SCOPE_AGENT); }
__device__ __forceinline__ unsigned xb_xcc_id() { return (unsigned)__builtin_amdgcn_s_getreg((3 << 11) | 20) & 0xFu; }
#define XB_SPIN(cond, bar) do { unsigned _sp = 0; while (cond) { __builtin_amdgcn_s_sleep(1); \
    if ((++_sp & 255u) == 0u) { if (xb_ld(&(bar)[XB_TMO])) break; if (_sp > XB_SPIN_CAP) { atomicAdd(&(bar)[XB_TMO], 1u); break; } } } } while (0)

struct XcdBarrier {
    unsigned* bar; unsigned x;
    volatile LAS unsigned* st;
};

__device__ __forceinline__ XcdBarrier xcd_barrier_post(unsigned* bar, volatile LAS unsigned* st) {
    XcdBarrier b; b.bar = bar; b.x = xb_xcc_id(); b.st = st;
    if (threadIdx.x == 0) (void)xb_add(&bar[XB_XCNT(b.x)], 1u);
    return b;
}
__device__ __forceinline__ void xcd_barrier_complete(unsigned* bar, unsigned x, unsigned& nloc, unsigned& nx) {
    const unsigned G = gridDim.x * gridDim.y * gridDim.z;
    unsigned sum, cnt, mine, sp = 0u;
    for (;;) {
        sum = 0u; cnt = 0u; mine = 0u;
#pragma unroll
        for (unsigned j = 0; j < 16; ++j) { const unsigned c = xb_ld(&bar[XB_XCNT(j)]); sum += c; cnt += (c > 0u) ? 1u : 0u; mine = (j == x) ? c : mine; }
        if (sum == G) break;
        __builtin_amdgcn_s_sleep(1);
        if ((++sp & 255u) == 0u) { if (xb_ld(&bar[XB_TMO])) break; if (sp > XB_SPIN_CAP) { atomicAdd(&bar[XB_TMO], 1u); break; } }
    }
    nloc = mine > 0u ? mine : 1u; nx = cnt > 0u ? cnt : 1u;
}

__device__ __forceinline__ void xcd_barrier(const XcdBarrier& b) {
    asm volatile("s_waitcnt vmcnt(0)" ::: "memory");
    __syncthreads();
    if (threadIdx.x == 0) {
        unsigned* bar = b.bar;
        __builtin_amdgcn_s_waitcnt(0);
        unsigned nloc = b.st[0], nx = b.st[1];
        if (nloc == 0u) { xcd_barrier_complete(bar, b.x, nloc, nx); b.st[0] = nloc; b.st[1] = nx; }
        const unsigned old = xb_add(&bar[XB_XSUB(b.x)], 1u);
        const unsigned gen = old / nloc;
        if (old + 1u == (gen + 1u) * nloc) {
            __builtin_amdgcn_fence(__ATOMIC_RELEASE, "agent");
            asm volatile("s_waitcnt vmcnt(0)" ::: "memory");
            const unsigned og = xb_add(&bar[XB_TOP], 1u);
            const unsigned tg = og / nx;
            if (og + 1u == (tg + 1u) * nx) xb_add(&bar[XB_TOPGEN], 1u);
            else XB_SPIN(xb_ld(&bar[XB_TOPGEN]) == tg, bar);
            __builtin_amdgcn_fence(__ATOMIC_ACQUIRE, "agent");
            xb_add(&bar[XB_XGEN(b.x)], 1u);
            asm volatile("s_waitcnt vmcnt(0)" ::: "memory");
        } else {
            XB_SPIN(xb_ld(&bar[XB_XGEN(b.x)]) == gen, bar);
            __builtin_amdgcn_fence(__ATOMIC_ACQUIRE, "agent");
            asm volatile("s_waitcnt vmcnt(0)" ::: "memory");
        }
    }
    __syncthreads();
}
struct Args { const float* in[25]; float* out; unsigned char* ws; int l_lo, l_hi, h_lo, h_hi, p_lo, p_hi, use_bar, pad; };

__device__ __forceinline__ void cvt_tile(const float* colp, int ldw, const float* gain, float nsc, int k0, bf16_t* dst, int K, LAS float* scr, int lane) {
#pragma unroll
    for (int i = 0; i < 32; ++i) { const int kk = 2 * i + (lane >> 5); const float g = gain ? gain[k0 + kk] * nsc : nsc; scr[kk * 33 + (lane & 31)] = colp[(size_t)(k0 + kk) * ldw] * g; }
    LDS_WAIT(); asm volatile("" ::: "memory");
    const int c = lane & 7;
#pragma unroll
    for (int j = 0; j < 4; ++j) { const int n = (lane >> 3) + 8 * j; const LAS float* s = scr + (8 * c) * 33 + n;
        u32x4 o; o.x = pk2(s[0 * 33], s[1 * 33]); o.y = pk2(s[2 * 33], s[3 * 33]); o.z = pk2(s[4 * 33], s[5 * 33]); o.w = pk2(s[6 * 33], s[7 * 33]);
        *(u32x4*)(dst + (size_t)n * K + 8 * c) = o; }
    LDS_WAIT(); asm volatile("" ::: "memory");
}
__device__ __forceinline__ void phase_convert(const Args& A, int l, LAS unsigned char* lds, int tid, int lane, int wave, int it_lo, int it_hi, int prologue) {
    unsigned char* ws = A.ws;
    LAS float* scr = (LAS float*)(lds + wave * 16384);
    const int gw = blockIdx.x * NWAVES + wave, NGW = gridDim.x * NWAVES;
    constexpr int I_WIN = 32 * 192, I_WOUT = 32 * 64, I_WGU = 32 * 352, I_WDN = 88 * 64, I_LRU = 256;
    constexpr int NITEMS = I_WIN + I_WOUT + I_WGU + I_WDN + I_LRU;
    static_assert(NITEMS == 25344, "item list");
    for (int it = it_lo + gw; it < it_hi; it += NGW) {
        int r = it;
        if (r < I_WIN) { const int kb = r / 192, nb = r % 192, n = 32 * nb + (lane & 31); int src = n; float nsc = 1.f;
            if (n < 2048) { const int sec = n >> 10, w = n & 1023, head = w >> 7, p = w & 127; src = sec * 1024 + head * 128 + 64 * ((p >> 2) & 1) + 16 * (p >> 5) + 4 * ((p >> 3) & 3) + (p & 3); nsc = sec ? 0.08838834764831845f : 1.f; }
            cvt_tile(A.in[3] + (size_t)l * 2048 * 6144 + src, 6144, A.in[2] + l * 2048, nsc, 64 * kb, (bf16_t*)(ws + WS_WIN) + (size_t)(32 * nb) * 2048 + 64 * kb, 2048, scr, lane); continue; }
        r -= I_WIN;
        if (r < I_WOUT) { const int kb = r / 64, nb = r % 64, n = 32 * nb + (lane & 31);
            cvt_tile(A.in[18] + (size_t)l * 2048 * 2048 + n, 2048, nullptr, 1.f, 64 * kb, (bf16_t*)(ws + WS_WOUT) + (size_t)(32 * nb) * 2048 + 64 * kb, 2048, scr, lane); continue; }
        r -= I_WOUT;
        if (r < I_WGU) { const int kb = r / 352, nb = r % 352, n = 32 * nb + (lane & 31); const int pn = n >> 8, bj = (n >> 7) & 1, c = n & 127;
            const float* W = (bj ? A.in[22] : A.in[21]) + (size_t)l * 2048 * 5632 + 128 * pn + c;
            cvt_tile(W, 5632, A.in[20] + l * 2048, 1.f, 64 * kb, (bf16_t*)(ws + WS_WGU) + (size_t)(32 * nb) * 2048 + 64 * kb, 2048, scr, lane); continue; }
        r -= I_WGU;
        if (r < I_WDN) { const int kb = r / 64, nb = r % 64, n = 32 * nb + (lane & 31);
            cvt_tile(A.in[23] + (size_t)l * 5632 * 2048 + n, 2048, nullptr, 1.f, 64 * kb, (bf16_t*)(ws + WS_WDN) + (size_t)(32 * nb) * 5632 + 64 * kb, 5632, scr, lane); continue; }
        r -= I_WDN;
        { const int mat = r >> 3, g = mat >> 2, gate = mat & 3, sub = r & 7, kb = sub >> 2, nb = sub & 3, n = 32 * nb + (lane & 31);
            const float* W = (gate == 0 ? A.in[7] : gate == 1 ? A.in[9] : gate == 2 ? A.in[12] : A.in[14]) + (size_t)(l * 8 + g) * 128 * 128 + n;
            cvt_tile(W, 128, nullptr, 1.f, 64 * kb, (bf16_t*)(ws + WS_WLRU) + (size_t)(mat * 128 + 32 * nb) * 128 + 64 * kb, 128, scr, lane); }
    }
    if (prologue & 1) {
        float* cosT = (float*)(ws + WS_COS); float* sinT = (float*)(ws + WS_SIN);
        for (int i = blockIdx.x * NTHR + tid; i < 8192 * 64; i += gridDim.x * NTHR) { const int pos = i >> 6, j = i & 63;
            const float inv = __builtin_amdgcn_exp2f(-(float)j * 0.20762050593046014f); const float ang = (float)pos * inv;
            const double rev = (double)ang * 0.15915494309189535; const float fr = (float)(rev - floor(rev));
            cosT[i] = __builtin_amdgcn_cosf(fr); sinT[i] = __builtin_amdgcn_sinf(fr); }
    }
    if (prologue & 6) {
        float* rstat = (float*)(ws + WS_RSTAT); bf16_t* xb = (bf16_t*)(ws + WS_XB);
        const int m_lo = (prologue & 2) ? 0 : HROWS, m_hi = (prologue & 4) ? 2 * HROWS : HROWS;
        for (int m = m_lo + gw; m < m_hi; m += NGW) {
            const float* xr = (m < HROWS ? A.in[0] + (size_t)m * DM : A.in[1] + (size_t)(m - HROWS) * DM);
            f32x4 v[8]; float ss = 0.f;
#pragma unroll
            for (int j = 0; j < 8; ++j) { v[j] = ((const f32x4*)xr)[lane + 64 * j]; ss += (v[j][0] * v[j][0] + v[j][1] * v[j][1]) + (v[j][2] * v[j][2] + v[j][3] * v[j][3]); }
            ss = wave_sum(ss);
            u32x2* o = (u32x2*)(xb + (size_t)m * DM);
#pragma unroll
            for (int j = 0; j < 8; ++j) { u32x2 w; w.x = pk2(v[j][0], v[j][1]); w.y = pk2(v[j][2], v[j][3]); o[lane + 64 * j] = w; }
            if (lane == 0) rstat[m] = 1.0f / sqrtf(ss * (1.0f / DM) + EPS);
        }
    }
}

__device__ __forceinline__ void phase_residual(bf16_t* xb, const bf16_t* br, const float* gain, float* rstat, float* xf32, int lane, int wave, int nrows = HROWS) {
    const int gw = blockIdx.x * NWAVES + wave, NGW = gridDim.x * NWAVES;
    f32x4 g[8];
#pragma unroll
    for (int j = 0; j < 4; ++j) { g[2 * j] = ((const f32x4*)gain)[2 * (lane + 64 * j)]; g[2 * j + 1] = ((const f32x4*)gain)[2 * (lane + 64 * j) + 1]; }
    u32x4 bn[4], xn[4];
    if (gw < nrows) {
#pragma unroll
        for (int j = 0; j < 4; ++j) { bn[j] = ((const u32x4*)(br + (size_t)gw * DM))[lane + 64 * j]; xn[j] = ((const u32x4*)(xb + (size_t)gw * DM))[lane + 64 * j]; } }
#pragma unroll 1
    for (int m = gw; m < nrows; m += NGW) {
        u32x4* xp = (u32x4*)(xb + (size_t)m * DM);
        u32x4 b[4], xv[4]; float ss = 0.f;
#pragma unroll
        for (int j = 0; j < 4; ++j) { b[j] = bn[j]; xv[j] = xn[j]; }
        if (m + NGW < nrows) {
#pragma unroll
            for (int j = 0; j < 4; ++j) { bn[j] = ((const u32x4*)(br + (size_t)(m + NGW) * DM))[lane + 64 * j]; xn[j] = ((const u32x4*)(xb + (size_t)(m + NGW) * DM))[lane + 64 * j]; } }
        f32x4 f[8], x[8];
#pragma unroll
        for (int j = 0; j < 4; ++j) { f[2 * j] = (f32x4){bflo(b[j].x), bfhi(b[j].x), bflo(b[j].y), bfhi(b[j].y)}; f[2 * j + 1] = (f32x4){bflo(b[j].z), bfhi(b[j].z), bflo(b[j].w), bfhi(b[j].w)};
            x[2 * j] = (f32x4){bflo(xv[j].x), bfhi(xv[j].x), bflo(xv[j].y), bfhi(xv[j].y)}; x[2 * j + 1] = (f32x4){bflo(xv[j].z), bfhi(xv[j].z), bflo(xv[j].w), bfhi(xv[j].w)}; }
#pragma unroll
        for (int j = 0; j < 8; ++j) ss += (f[j][0] * f[j][0] + f[j][1] * f[j][1]) + (f[j][2] * f[j][2] + f[j][3] * f[j][3]);
        const float s = 1.0f / sqrtf(wave_sum(ss) * (1.0f / DM) + EPS);
        float s2 = 0.f;
#pragma unroll
        for (int j = 0; j < 8; ++j) { x[j] = x[j] + f[j] * s * g[j]; s2 += (x[j][0] * x[j][0] + x[j][1] * x[j][1]) + (x[j][2] * x[j][2] + x[j][3] * x[j][3]); }
        if (xf32) { f32x4* op = (f32x4*)(xf32 + (size_t)m * DM);
#pragma unroll
            for (int j = 0; j < 4; ++j) { op[2 * (lane + 64 * j)] = x[2 * j]; op[2 * (lane + 64 * j) + 1] = x[2 * j + 1]; }
        } else {
            s2 = wave_sum(s2);
#pragma unroll
            for (int j = 0; j < 4; ++j) { u32x4 w; w.x = pk2(x[2 * j][0], x[2 * j][1]); w.y = pk2(x[2 * j][2], x[2 * j][3]); w.z = pk2(x[2 * j + 1][0], x[2 * j + 1][1]); w.w = pk2(x[2 * j + 1][2], x[2 * j + 1][3]); xp[lane + 64 * j] = w; }
            if (lane == 0) rstat[m] = 1.0f / sqrtf(s2 * (1.0f / DM) + EPS);
        }
    }
}
__device__ __forceinline__ float head_l2g(int head) { return __builtin_log2f(1.0f - __builtin_exp2f(-5.0f - (float)head)); }

__device__ __forceinline__ void b1_chunk(LAS unsigned char* lds, const bf16_t* proj, bf16_t* st, int ck, int tid_in) {
    LAS unsigned char* imV = lds; LAS unsigned char* imKf = lds + 32768; LAS unsigned char* imKb = lds + 65536;
    u32x4 pf[8];
    {   int tid = tid_in; asm volatile("" : "+v"(tid)); const bf16_t* Kg = proj + (size_t)(ck * 128) * INW + 1024;
#pragma unroll
        for (int i = 0; i < 4; ++i) { const int q = tid + 512 * i, row = q >> 4, ch = q & 15; pf[i] = *(const u32x4*)(Kg + (size_t)row * INW + ch * 8); pf[4 + i] = *(const u32x4*)(Kg + 1024 + (size_t)row * INW + ch * 8); } }
#pragma unroll 1
    for (int head = 0; head < 8; ++head) {
        int tid = tid_in; asm volatile("" : "+v"(tid)); const int lane = tid & 63, wid = __builtin_amdgcn_readfirstlane(tid >> 6);
        const float l2g = head_l2g(head);
        __syncthreads();
#pragma unroll
        for (int i = 0; i < 4; ++i) { const int q = tid + 512 * i, row = q >> 4, ch = q & 15; const u32x4 kv = pf[i];
            const float sf = fexp2(l2g * (float)(127 - row)), sb = fexp2(l2g * (float)row); const unsigned off = off_b(row, ch);
            *(LAS u32x4*)(imV + off) = pf[4 + i];
            u32x4 kf, kb;
            kf.x = pk2(bflo(kv.x) * sf, bfhi(kv.x) * sf); kf.y = pk2(bflo(kv.y) * sf, bfhi(kv.y) * sf); kf.z = pk2(bflo(kv.z) * sf, bfhi(kv.z) * sf); kf.w = pk2(bflo(kv.w) * sf, bfhi(kv.w) * sf);
            kb.x = pk2(bflo(kv.x) * sb, bfhi(kv.x) * sb); kb.y = pk2(bflo(kv.y) * sb, bfhi(kv.y) * sb); kb.z = pk2(bflo(kv.z) * sb, bfhi(kv.z) * sb); kb.w = pk2(bflo(kv.w) * sb, bfhi(kv.w) * sb);
            *(LAS u32x4*)(imKf + off) = kf; *(LAS u32x4*)(imKb + off) = kb; }
        __syncthreads();
        if (head < 7) { const bf16_t* Kg = proj + (size_t)(ck * 128) * INW + 1024 + (head + 1) * 128;
#pragma unroll
            for (int i = 0; i < 4; ++i) { const int q = tid + 512 * i, row = q >> 4, ch = q & 15; pf[i] = *(const u32x4*)(Kg + (size_t)row * INW + ch * 8); pf[4 + i] = *(const u32x4*)(Kg + 1024 + (size_t)row * INW + ch * 8); } }
        const int wr = wid >> 2, wc = wid & 3, fr = lane & 15, fq = lane >> 4;
        f32x4 accf[4][2], accb[4][2];
#pragma unroll
        for (int a = 0; a < 4; ++a)
#pragma unroll
            for (int b = 0; b < 2; ++b) { accf[a][b] = (f32x4){0.f, 0.f, 0.f, 0.f}; accb[a][b] = (f32x4){0.f, 0.f, 0.f, 0.f}; }
#pragma unroll
        for (int ks = 0; ks < 4; ++ks) {
            s16x8 Y[2], Xf[4], Xb[4];
#pragma unroll
            for (int nt = 0; nt < 2; ++nt) Y[nt] = tr_frag(imV, 2 * wc + nt, ks, lane);
#pragma unroll
            for (int mt = 0; mt < 4; ++mt) { Xf[mt] = tr_frag(imKf, 4 * wr + mt, ks, lane); Xb[mt] = tr_frag(imKb, 4 * wr + mt, ks, lane); }
#pragma unroll
            for (int mt = 0; mt < 4; ++mt)
#pragma unroll
                for (int nt = 0; nt < 2; ++nt) { accf[mt][nt] = MFMA16(Xf[mt], Y[nt], accf[mt][nt]); accb[mt][nt] = MFMA16(Xb[mt], Y[nt], accb[mt][nt]); }
        }
        bf16_t* stf = st + ((size_t)(ck * 8 + head) * 2) * 16384; bf16_t* stb = stf + 16384;
#pragma unroll
        for (int mt = 0; mt < 4; ++mt)
#pragma unroll
            for (int nt = 0; nt < 2; ++nt) { const int d = 64 * wr + 16 * mt + 4 * fq, e = 32 * wc + 16 * nt + fr;
                u32x2 w; w.x = pk2(accf[mt][nt][0], accf[mt][nt][1]); w.y = pk2(accf[mt][nt][2], accf[mt][nt][3]); *(u32x2*)(stf + e * 128 + d) = w;
                w.x = pk2(accb[mt][nt][0], accb[mt][nt][1]); w.y = pk2(accb[mt][nt][2], accb[mt][nt][3]); *(u32x2*)(stb + e * 128 + d) = w; }
    }
    __syncthreads();
}

struct LruP { const float* conv_w; const float* conv_b; const float* ba[2]; const float* bx[2]; const float* lam[2]; };
__device__ __forceinline__ void l1_unit(LAS unsigned char* lds, const bf16_t* proj, const bf16_t* Wl, bf16_t* lbuf, float* agg, const LruP& P, int ck, int smask, int tid_in) {
    const int r0 = ck * 128, pos0 = r0 & smask, S = smask + 1;
    u32x4 un[7];
    {   int tid = tid_in; asm volatile("" : "+v"(tid)); const int ch = tid & 15, tg = tid >> 4;
#pragma unroll
        for (int j = 0; j < 7; ++j) { const int t = 4 * tg - 2 + j, pos = pos0 + t; un[j] = (u32x4){0u, 0u, 0u, 0u};
            if (pos >= 0 && pos < S) un[j] = *(const u32x4*)(proj + (size_t)(r0 + t) * INW + 4096 + ch * 8); } }
#pragma unroll 1
    for (int g = 0; g < 8; ++g) {
        int tid = tid_in; asm volatile("" : "+v"(tid)); int lane = tid & 63, fr = lane & 15, fq = lane >> 4; const int wid = __builtin_amdgcn_readfirstlane(tid >> 6);
        LAS unsigned char* imU = lds + (g & 1) * 32768; LAS unsigned char* sY = lds + 65536 + wid * 8448; LAS unsigned char* sF = sY + 4224; LAS unsigned char* sB = sF + 2112;
        const int cb = 16 * wid + fr, c = g * 128 + cb;
        s16x8 Bw[2][4];
#pragma unroll
        for (int gt = 0; gt < 2; ++gt)
#pragma unroll
            for (int ks = 0; ks < 4; ++ks) Bw[gt][ks] = *(const s16x8*)(Wl + ((size_t)((g * 4 + gt) * 128 + cb)) * 128 + 32 * ks + 8 * fq);
        {   const int ch = tid & 15, tg = tid >> 4, c0 = g * 128 + ch * 8; u32x4 u[7];
#pragma unroll
            for (int j = 0; j < 7; ++j) u[j] = un[j];
            const f32x4 b0 = *(const f32x4*)(P.conv_b + c0), b1 = *(const f32x4*)(P.conv_b + c0 + 4);
            f32x4 a0[4], a1[4];
#pragma unroll
            for (int o = 0; o < 4; ++o) { a0[o] = b0; a1[o] = b1; }
#pragma unroll
            for (int k = 0; k < 4; ++k) { const f32x4 w0 = *(const f32x4*)(P.conv_w + k * 1024 + c0), w1 = *(const f32x4*)(P.conv_w + k * 1024 + c0 + 4);
#pragma unroll
                for (int o = 0; o < 4; ++o) { const u32x4 v = u[o + k];
                    a0[o] += (f32x4){bflo(v.x), bfhi(v.x), bflo(v.y), bfhi(v.y)} * w0; a1[o] += (f32x4){bflo(v.z), bfhi(v.z), bflo(v.w), bfhi(v.w)} * w1; } }
#pragma unroll
            for (int o = 0; o < 4; ++o) { u32x4 w; w.x = pk2(a0[o][0], a0[o][1]); w.y = pk2(a0[o][2], a0[o][3]); w.z = pk2(a1[o][0], a1[o][1]); w.w = pk2(a1[o][2], a1[o][3]);
                *(LAS u32x4*)(imU + off_b((unsigned)(4 * tg + o), (unsigned)ch)) = w; } }
        __syncthreads();
        if (g < 7) { const int ch = tid & 15, tg = tid >> 4;
#pragma unroll
            for (int j = 0; j < 7; ++j) { const int t = 4 * tg - 2 + j, pos = pos0 + t; un[j] = (u32x4){0u, 0u, 0u, 0u};
                if (pos >= 0 && pos < S) un[j] = *(const u32x4*)(proj + (size_t)(r0 + t) * INW + 4096 + (g + 1) * 128 + ch * 8); } }
#pragma unroll
        for (int dir = 0; dir < 2; ++dir) {
            { int t2 = tid; asm volatile("" : "+v"(t2)); lane = t2 & 63; fr = lane & 15; fq = lane >> 4; }
            f32x4 acc[8][2];
#pragma unroll
            for (int m = 0; m < 8; ++m) { acc[m][0] = (f32x4){0.f, 0.f, 0.f, 0.f}; acc[m][1] = (f32x4){0.f, 0.f, 0.f, 0.f}; }
#pragma unroll
            for (int ks = 0; ks < 4; ++ks) {
#pragma unroll
                for (int m = 0; m < 8; ++m) { const s16x8 Af = *(LAS s16x8*)(imU + off_b((unsigned)(32 * (fr >> 2) + 4 * m + (fr & 3)), (unsigned)(4 * ks + fq)));
                    acc[m][0] = MFMA16(Af, Bw[0][ks], acc[m][0]); acc[m][1] = MFMA16(Af, Bw[1][ks], acc[m][1]); } }
            if (dir == 0) {
#pragma unroll
                for (int gt = 0; gt < 2; ++gt)
#pragma unroll
                    for (int ks = 0; ks < 4; ++ks) Bw[gt][ks] = *(const s16x8*)(Wl + ((size_t)((g * 4 + 2 + gt) * 128 + cb)) * 128 + 32 * ks + 8 * fq); }
            const float nba = -1.44269504089f * P.ba[dir][c], nbx = -1.44269504089f * P.bx[dir][c], lam = P.lam[dir][c];
            const float c8sp = -8.0f * 1.44269504089f * log1pf(expf(-lam));
            float Pseg = 1.f, Eseg = 0.f;
#pragma unroll
            for (int mm = 0; mm < 8; ++mm) { const int m = dir ? 7 - mm : mm;
                const unsigned q = ((unsigned)lane & 15u) >> 2, p = (unsigned)lane & 3u;
                const s16x4 t = __builtin_amdgcn_ds_read_tr16_b64_v4i16((LAS s16x4*)(imU + off_b(32u * fq + 4u * m + q, 2u * wid + (p >> 1)) + 8u * (p & 1u)));
#pragma unroll
                for (int rr = 0; rr < 4; ++rr) { const int r = dir ? 3 - rr : rr;
                    const float ucv = __uint_as_float(((unsigned)(unsigned short)t[r]) << 16);
                    const float rg = __builtin_amdgcn_rcpf(1.0f + fexp2(fmaf(acc[m][0][r], -1.44269504089f, nba))), ig = __builtin_amdgcn_rcpf(1.0f + fexp2(fmaf(acc[m][1][r], -1.44269504089f, nbx)));
                    const float a = fexp2(c8sp * rg), b = __builtin_amdgcn_sqrtf(fmaxf(fmaf(-a, a, 1.0f), 0.0f)) * (ig * ucv);
                    acc[m][0][r] = a; acc[m][1][r] = b; Eseg = fmaf(a, Eseg, b); Pseg *= a; } }
            float Ps[4], Es[4];
#pragma unroll
            for (int s = 0; s < 4; ++s) { Ps[s] = __shfl(Pseg, fr + 16 * s); Es[s] = __shfl(Eseg, fr + 16 * s); }
            float Apre = 1.f, hpre = 0.f, Pall = 1.f, Eall = 0.f;
#pragma unroll
            for (int ss = 0; ss < 4; ++ss) { const int s = dir ? 3 - ss : ss;
                const bool before = dir ? (s > fq) : (s < fq);
                if (before) { hpre = fmaf(hpre, Ps[s], Es[s]); Apre *= Ps[s]; }
                Eall = fmaf(Eall, Ps[s], Es[s]); Pall *= Ps[s]; }
            if (fq == 0) { agg[((size_t)(ck * 2 + dir) * 2 + 0) * 1024 + c] = Pall; agg[((size_t)(ck * 2 + dir) * 2 + 1) * 1024 + c] = Eall; }
            LAS unsigned char* sA = (dir ? sB : sF) + fq * 528 + fr;
            LAS unsigned char* sy = sY + fq * 1056 + fr * 2;
            float Acum = Apre, h = hpre;
#pragma unroll
            for (int mm = 0; mm < 8; ++mm) { const int m = dir ? 7 - mm : mm;
#pragma unroll
                for (int rr = 0; rr < 4; ++rr) { const int r = dir ? 3 - rr : rr; const int kk = 4 * m + r;
                    Acum *= acc[m][0][r]; h = fmaf(acc[m][0][r], h, acc[m][1][r]);
                    *(LAS unsigned char*)(sA + kk * 16) = (unsigned char)(unsigned)(Acum * 255.0f + 0.5f);
                    float yv = h;
                    if (dir == 1) yv += __uint_as_float(((unsigned)*(LAS unsigned short*)(sy + kk * 32)) << 16);
                    *(LAS unsigned short*)(sy + kk * 32) = (unsigned short)(pk2(yv, 0.f) & 0xffffu); } }
        }
        asm volatile("s_waitcnt lgkmcnt(0)" ::: "memory");
        {
            const int p = lane & 3; unsigned char* l8 = (unsigned char*)lbuf;
#pragma unroll
            for (int it = 0; it < 8; ++it) { const int tok = 16 * it + (lane >> 2), fb = tok >> 5, kk = tok & 31;
                const unsigned so = p < 2 ? (unsigned)(fb * 1056 + kk * 32 + 16 * p) : (unsigned)((p == 2 ? 4224 : 6336) + fb * 528 + kk * 16);
                *(u32x4*)(l8 + (((size_t)(r0 + tok) * 64 + (g * 8 + wid)) * 64 + 16 * p)) = *(LAS u32x4*)(sY + so); } }
        asm volatile("" ::: "memory");
    }
    __syncthreads();
}

__device__ __forceinline__ void b2_item(bf16_t* st, int b, int head, int dir, int slice, int Nc, int tid) {
    const float gC = fexp2(head_l2g(head) * 128.0f);
    bf16_t* base = st + ((size_t)((b * Nc) * 8 + head) * 2 + dir) * 16384 + slice * 4096 + tid * 8;
    const size_t cstride = (size_t)8 * 2 * 16384;
    float s[8];
#pragma unroll
    for (int j = 0; j < 8; ++j) s[j] = 0.f;
    for (int n0 = 0; n0 < Nc; n0 += 16) {
        u32x4 v[16];
#pragma unroll
        for (int u = 0; u < 16; ++u) { const int n = dir ? Nc - 1 - (n0 + u) : n0 + u; v[u] = *(const u32x4*)(base + (size_t)n * cstride); }
#pragma unroll
        for (int u = 0; u < 16; ++u) { const int n = dir ? Nc - 1 - (n0 + u) : n0 + u;
            u32x4 o; o.x = pk2(s[0], s[1]); o.y = pk2(s[2], s[3]); o.z = pk2(s[4], s[5]); o.w = pk2(s[6], s[7]); *(u32x4*)(base + (size_t)n * cstride) = o;
            s[0] = fmaf(s[0], gC, bflo(v[u].x)); s[1] = fmaf(s[1], gC, bfhi(v[u].x)); s[2] = fmaf(s[2], gC, bflo(v[u].y)); s[3] = fmaf(s[3], gC, bfhi(v[u].y));
            s[4] = fmaf(s[4], gC, bflo(v[u].z)); s[5] = fmaf(s[5], gC, bfhi(v[u].z)); s[6] = fmaf(s[6], gC, bflo(v[u].w)); s[7] = fmaf(s[7], gC, bfhi(v[u].w)); }
    }
}
__device__ __forceinline__ void phase_scans(bf16_t* st, const float* agg, float* carry, int nseq, int Nc, int tid) {
    const int nitems = nseq * 64;
    for (int it = blockIdx.x; it < nitems; it += gridDim.x) { const int slice = it & 3, dir = (it >> 2) & 1, head = (it >> 3) & 7, b = it >> 6; b2_item(st, b, head, dir, slice, Nc, tid); }
    const int nthr = nseq * 2048;
    for (int i = blockIdx.x * NTHR + tid; i < nthr; i += gridDim.x * NTHR) { const int c = i & 1023, dir = (i >> 10) & 1, b = i >> 11; float H = 0.f;
        for (int n0 = 0; n0 < Nc; n0 += 8) { float Pv[8], Ev[8];
#pragma unroll
            for (int u = 0; u < 8; ++u) { const int n = dir ? Nc - 1 - (n0 + u) : n0 + u, ck = b * Nc + n;
                Pv[u] = agg[((size_t)(ck * 2 + dir) * 2 + 0) * 1024 + c]; Ev[u] = agg[((size_t)(ck * 2 + dir) * 2 + 1) * 1024 + c]; }
#pragma unroll
            for (int u = 0; u < 8; ++u) { const int n = dir ? Nc - 1 - (n0 + u) : n0 + u, ck = b * Nc + n;
                carry[(size_t)(ck * 2 + dir) * 1024 + c] = H; H = fmaf(H, Pv[u], Ev[u]); } } }
}
__device__ __forceinline__ void b3_chunk(LAS unsigned char* lds, const bf16_t* proj, const bf16_t* st, bf16_t* mix, const float* rnorm, int ck, int tid_in) {
    LAS unsigned char* imK = lds; LAS unsigned char* imV = lds + 32768; LAS unsigned char* imSf = lds + 65536; LAS unsigned char* imSb = lds + 98304;
    u32x4 pf[16]; s16x8 Yqn[4];
    {   int tid = tid_in; asm volatile("" : "+v"(tid)); const int lane = tid & 63, wid = __builtin_amdgcn_readfirstlane(tid >> 6);
        if (tid < 256) *(LAS f32x4*)(lds + LDS_WORK + 1024 + tid * 16) = *(const f32x4*)(rnorm + tid * 4);
#pragma unroll
        for (int ks = 0; ks < 4; ++ks) Yqn[ks] = *(const s16x8*)(proj + (size_t)(ck * 128 + 16 * wid + (lane & 15)) * INW + 32 * ks + 8 * (lane >> 4));
        const bf16_t* Kg = proj + (size_t)(ck * 128) * INW + 1024; const bf16_t* sg = st + ((size_t)(ck * 8) * 2) * 16384;
#pragma unroll
        for (int i = 0; i < 4; ++i) { const int q = tid + 512 * i, row = q >> 4, ch = q & 15;
            pf[i] = *(const u32x4*)(Kg + (size_t)row * INW + ch * 8); pf[4 + i] = *(const u32x4*)(Kg + 1024 + (size_t)row * INW + ch * 8);
            pf[8 + i] = *(const u32x4*)(sg + row * 128 + ch * 8); pf[12 + i] = *(const u32x4*)(sg + 16384 + row * 128 + ch * 8); } }
#pragma unroll 1
    for (int head = 0; head < 8; ++head) {
        int tid = tid_in; asm volatile("" : "+v"(tid)); const int lane = tid & 63, wid = __builtin_amdgcn_readfirstlane(tid >> 6), fr = lane & 15, fq = lane >> 4;
        const float l2g = head_l2g(head);
        const bf16_t* Qg = proj + (size_t)(ck * 128) * INW + head * 128;
        __syncthreads();
#pragma unroll
        for (int i = 0; i < 4; ++i) { const int q = tid + 512 * i, row = q >> 4, ch = q & 15; const unsigned off = off_b(row, ch);
            *(LAS u32x4*)(imK + off) = pf[i]; *(LAS u32x4*)(imV + off) = pf[4 + i]; *(LAS u32x4*)(imSf + off) = pf[8 + i]; *(LAS u32x4*)(imSb + off) = pf[12 + i]; }
        const int i_tok = 16 * wid + fr;
        s16x8 Yq[4];
#pragma unroll
        for (int ks = 0; ks < 4; ++ks) Yq[ks] = Yqn[ks];
        __syncthreads();
        const bf16_t* Gg = Qg + 3072 + (size_t)i_tok * INW;
        u32x2 gv[8];
#pragma unroll
        for (int et = 0; et < 8; ++et) gv[et] = *(const u32x2*)(Gg + 16 * et + 4 * fq);
        if (head < 7) {
            const bf16_t* Kg = proj + (size_t)(ck * 128) * INW + 1024 + (head + 1) * 128; const bf16_t* sg = st + ((size_t)(ck * 8 + head + 1) * 2) * 16384;
#pragma unroll
            for (int ks = 0; ks < 4; ++ks) Yqn[ks] = *(const s16x8*)(Qg + 128 + (size_t)i_tok * INW + 32 * ks + 8 * fq);
#pragma unroll
            for (int i = 0; i < 4; ++i) { const int q = tid + 512 * i, row = q >> 4, ch = q & 15;
                pf[i] = *(const u32x4*)(Kg + (size_t)row * INW + ch * 8); pf[4 + i] = *(const u32x4*)(Kg + 1024 + (size_t)row * INW + ch * 8);
                pf[8 + i] = *(const u32x4*)(sg + row * 128 + ch * 8); pf[12 + i] = *(const u32x4*)(sg + 16384 + row * 128 + ch * 8); } }
        s16x8 Yp[4];
        {   f32x4 accP[8];
#pragma unroll
            for (int jt = 0; jt < 8; ++jt) accP[jt] = (f32x4){0.f, 0.f, 0.f, 0.f};
#pragma unroll
            for (int ks = 0; ks < 4; ++ks)
#pragma unroll
                for (int jt = 0; jt < 8; ++jt) { const unsigned j = 32u * (jt >> 1) + 8u * ((unsigned)fr >> 2) + 4u * (jt & 1) + ((unsigned)fr & 3u);
                    accP[jt] = MFMA16(*(LAS s16x8*)(imK + off_b(j, (unsigned)(4 * ks + fq))), Yq[ks], accP[jt]); }
#pragma unroll
            for (int ks = 0; ks < 4; ++ks) { float w[8];
#pragma unroll
                for (int t = 0; t < 2; ++t)
#pragma unroll
                    for (int r = 0; r < 4; ++r) { const int j = 32 * ks + 8 * fq + 4 * t + r, dd = i_tok - j; w[4 * t + r] = accP[2 * ks + t][r] * fexp2(l2g * (float)(dd < 0 ? -dd : dd)); }
                u32x4 o; o.x = pk2(w[0], w[1]); o.y = pk2(w[2], w[3]); o.z = pk2(w[4], w[5]); o.w = pk2(w[6], w[7]);
                Yp[ks] = __builtin_bit_cast(s16x8, o); }
        }
        f32x4 accI[8], accF[8];
#pragma unroll
        for (int et = 0; et < 8; ++et) { accI[et] = (f32x4){0.f, 0.f, 0.f, 0.f}; accF[et] = (f32x4){0.f, 0.f, 0.f, 0.f}; }
#pragma unroll
        for (int ks = 0; ks < 4; ++ks)
#pragma unroll
            for (int et = 0; et < 8; ++et) { accI[et] = MFMA16(tr_frag(imV, et, ks, lane), Yp[ks], accI[et]); accF[et] = MFMA16(row_frag(imSf, et, ks, lane), Yq[ks], accF[et]); }
        const float qf = fexp2(l2g * (float)(i_tok + 1)), qb = fexp2(l2g * (float)(128 - i_tok));
#pragma unroll
        for (int et = 0; et < 8; ++et) { accI[et] = accI[et] + accF[et] * qf; accF[et] = (f32x4){0.f, 0.f, 0.f, 0.f}; }
#pragma unroll
        for (int ks = 0; ks < 4; ++ks)
#pragma unroll
            for (int et = 0; et < 8; ++et) accF[et] = MFMA16(row_frag(imSb, et, ks, lane), Yq[ks], accF[et]);
        float ss = 0.f;
#pragma unroll
        for (int et = 0; et < 8; ++et) { accI[et] = accI[et] + accF[et] * qb; ss += (accI[et][0] * accI[et][0] + accI[et][1] * accI[et][1]) + (accI[et][2] * accI[et][2] + accI[et][3] * accI[et][3]); }
        ss += __shfl_xor(ss, 16); ss += __shfl_xor(ss, 32);
        const float sc = 1.0f / sqrtf(ss * (1.0f / 128.0f) + EPS);
        bf16_t* op = mix + (size_t)(ck * 128 + i_tok) * DM + head * 128;
#pragma unroll
        for (int et = 0; et < 8; ++et) { const int e = 16 * et + 4 * fq; const f32x4 rn = *(LAS f32x4*)(lds + LDS_WORK + 1024 + (head * 128 + e) * 4);
            const float g0 = bflo(gv[et].x), g1 = bfhi(gv[et].x), g2 = bflo(gv[et].y), g3 = bfhi(gv[et].y);
            u32x2 o; o.x = pk2(accI[et][0] * sc * rn[0] * (g0 * fsigmoid(g0)), accI[et][1] * sc * rn[1] * (g1 * fsigmoid(g1)));
            o.y = pk2(accI[et][2] * sc * rn[2] * (g2 * fsigmoid(g2)), accI[et][3] * sc * rn[3] * (g3 * fsigmoid(g3)));
            *(u32x2*)(op + e) = o; }
    }
    __syncthreads();
}
__device__ __forceinline__ float gelu_tanh(float x) { const float z = 0.7978845608028654f * (x + 0.044715f * x * x * x); const float t = 1.0f - 2.0f * __builtin_amdgcn_rcpf(1.0f + fexp2(2.885390081777927f * z)); return 0.5f * x * (1.0f + t); }
__device__ __forceinline__ void l3_rows(const bf16_t* proj, const bf16_t* lbuf, const float* carry, const float* lnorm, bf16_t* mix, int lane, int wave) {
    const int gw = blockIdx.x * NWAVES + wave, NGW = gridDim.x * NWAVES;
    const unsigned char* l8 = (const unsigned char*)lbuf;
    const int c0 = 16 * lane;
    for (int blk = gw; blk < HROWS / 16; blk += NGW) {
        const int m0 = blk * 16, ck = m0 >> 7;
        f32x4 hf[4], hb[4], ln[4];
#pragma unroll
        for (int q = 0; q < 4; ++q) { hf[q] = *(const f32x4*)(carry + (size_t)(ck * 2 + 0) * 1024 + c0 + 4 * q); hb[q] = *(const f32x4*)(carry + (size_t)(ck * 2 + 1) * 1024 + c0 + 4 * q); ln[q] = *(const f32x4*)(lnorm + c0 + 4 * q); }
        u32x4 rec[4], uy[2];
#pragma unroll
        for (int q = 0; q < 4; ++q) rec[q] = *(const u32x4*)(l8 + ((size_t)m0 * 64 + lane) * 64 + 16 * q);
        uy[0] = *(const u32x4*)(proj + (size_t)m0 * INW + 5120 + c0); uy[1] = *(const u32x4*)(proj + (size_t)m0 * INW + 5120 + c0 + 8);
#pragma unroll 1
        for (int k = 0; k < 16; ++k) { const int m = m0 + k;
            float y[16], gt[16]; float ss = 0.f;
            const float s8 = 1.0f / 255.0f;
#pragma unroll
            for (int q = 0; q < 4; ++q) {
                const unsigned yw0 = q < 2 ? (q == 0 ? rec[0].x : rec[0].z) : (q == 2 ? rec[1].x : rec[1].z), yw1 = q < 2 ? (q == 0 ? rec[0].y : rec[0].w) : (q == 2 ? rec[1].y : rec[1].w);
                const unsigned fw = q == 0 ? rec[2].x : q == 1 ? rec[2].y : q == 2 ? rec[2].z : rec[2].w, bw = q == 0 ? rec[3].x : q == 1 ? rec[3].y : q == 2 ? rec[3].z : rec[3].w;
                y[4 * q + 0] = bflo(yw0) + (float)(fw & 0xffu) * s8 * hf[q][0] + (float)(bw & 0xffu) * s8 * hb[q][0];
                y[4 * q + 1] = bfhi(yw0) + (float)((fw >> 8) & 0xffu) * s8 * hf[q][1] + (float)((bw >> 8) & 0xffu) * s8 * hb[q][1];
                y[4 * q + 2] = bflo(yw1) + (float)((fw >> 16) & 0xffu) * s8 * hf[q][2] + (float)((bw >> 16) & 0xffu) * s8 * hb[q][2];
                y[4 * q + 3] = bfhi(yw1) + (float)(fw >> 24) * s8 * hf[q][3] + (float)(bw >> 24) * s8 * hb[q][3]; }
#pragma unroll
            for (int j = 0; j < 2; ++j) { gt[8 * j + 0] = bflo(uy[j].x); gt[8 * j + 1] = bfhi(uy[j].x); gt[8 * j + 2] = bflo(uy[j].y); gt[8 * j + 3] = bfhi(uy[j].y);
                gt[8 * j + 4] = bflo(uy[j].z); gt[8 * j + 5] = bfhi(uy[j].z); gt[8 * j + 6] = bflo(uy[j].w); gt[8 * j + 7] = bfhi(uy[j].w); }
            if (k < 15) {
#pragma unroll
                for (int q = 0; q < 4; ++q) rec[q] = *(const u32x4*)(l8 + ((size_t)(m + 1) * 64 + lane) * 64 + 16 * q);
                uy[0] = *(const u32x4*)(proj + (size_t)(m + 1) * INW + 5120 + c0); uy[1] = *(const u32x4*)(proj + (size_t)(m + 1) * INW + 5120 + c0 + 8); }
#pragma unroll
            for (int q = 0; q < 16; ++q) ss += y[q] * y[q];
            const float sc = 1.0f / sqrtf(wave_sum(ss) * (1.0f / LRUW) + EPS);
            u32x4 o[2];
#pragma unroll
            for (int j = 0; j < 2; ++j) {
                o[j].x = pk2(y[8 * j + 0] * sc * ln[2 * j][0] * gelu_tanh(gt[8 * j + 0]), y[8 * j + 1] * sc * ln[2 * j][1] * gelu_tanh(gt[8 * j + 1]));
                o[j].y = pk2(y[8 * j + 2] * sc * ln[2 * j][2] * gelu_tanh(gt[8 * j + 2]), y[8 * j + 3] * sc * ln[2 * j][3] * gelu_tanh(gt[8 * j + 3]));
                o[j].z = pk2(y[8 * j + 4] * sc * ln[2 * j + 1][0] * gelu_tanh(gt[8 * j + 4]), y[8 * j + 5] * sc * ln[2 * j + 1][1] * gelu_tanh(gt[8 * j + 5]));
                o[j].w = pk2(y[8 * j + 6] * sc * ln[2 * j + 1][2] * gelu_tanh(gt[8 * j + 6]), y[8 * j + 7] * sc * ln[2 * j + 1][3] * gelu_tanh(gt[8 * j + 7])); }
            *(u32x4*)(mix + (size_t)m * DM + 1024 + c0) = o[0]; *(u32x4*)(mix + (size_t)m * DM + 1024 + c0 + 8) = o[1];
        }
    }
}
#ifndef WGM_NARROW
#define WGM_NARROW 4
#endif
__global__ void __launch_bounds__(NTHR, 2) hymba_fwd(Args A) {
    extern __shared__ __attribute__((aligned(16))) unsigned char lds_raw[];
    LAS unsigned char* lds = (LAS unsigned char*)lds_raw;
    volatile LAS unsigned* MISC = (volatile LAS unsigned*)(lds + LDS_WORK);
    unsigned char* ws = A.ws;
    const int wave0 = __builtin_amdgcn_readfirstlane((int)threadIdx.x >> 6);
    if (threadIdx.x < 64) MISC[threadIdx.x] = 0u;
    __syncthreads();
    XcdBarrier bar; bar.bar = (unsigned*)(ws + WS_CTL); bar.x = 0; bar.st = nullptr;
    if (A.use_bar) bar = xcd_barrier_post((unsigned*)(ws + WS_CTL), MISC);
#define GRID_BAR() do { if (A.use_bar) xcd_barrier(bar); else __syncthreads(); } while (0)
#define IN(k) (A.p_lo <= (k) && (k) < A.p_hi)
#define TIDS() int tid = wave0 * 64 + (int)__builtin_amdgcn_mbcnt_hi(~0u, __builtin_amdgcn_mbcnt_lo(~0u, 0u)); asm volatile("" : "+v"(tid)); const int lane = tid & 63, wave = __builtin_amdgcn_readfirstlane(tid >> 6); (void)lane; (void)wave
    float* rstat_all = (float*)(ws + WS_RSTAT);
    const float* cosT = (const float*)(ws + WS_COS); const float* sinT = (const float*)(ws + WS_SIN);
    float* agg = (float*)(ws + WS_AGG); float* carry = (float*)(ws + WS_CARRY);
    bf16_t* big = (bf16_t*)(ws + WS_BIG); bf16_t* st = (bf16_t*)(ws + WS_ST); bf16_t* lbuf = (bf16_t*)(ws + WS_LRU);

    { TIDS(); phase_convert(A, 0, lds, tid, lane, wave, 0, 25344, 7); GRID_BAR(); }
    bf16_t* xb_all = (bf16_t*)(ws + WS_XB); bf16_t* mix_all = (bf16_t*)A.out;
    bf16_t* fout = st;
    const bool oddwg = (blockIdx.x & 1) != 0;
    for (int l = 0; l < DEPTH; ++l) {
        const bool more = l + 1 < DEPTH;
        for (int h = 0; h < 2; ++h) {
            bf16_t* xb = xb_all + (size_t)h * HROWS * DM; float* rstat = rstat_all + h * HROWS; bf16_t* mixb = mix_all + (size_t)h * HROWS * DM;
            const int smask = h ? 8191 : 4095, nseq = h ? 4 : 8, Nc = h ? 64 : 32;
            {
                const bool side = (h == 0 && l > 0);
                if (side && oddwg) { TIDS(); phase_residual(xb_all + (size_t)HROWS * DM, fout, A.in[24] + (l - 1) * DM, rstat_all + HROWS, nullptr, lane, wave); phase_convert(A, l, lds, tid, lane, wave, 19456, 25088, 0); __syncthreads(); }
                {
                    pg8::Gemm g{xb, (const bf16_t*)(ws + WS_WIN), HROWS, INW, DM}; pg8::StaticOrder S; S.init(HROWS, INW, (int)gridDim.x, (int)blockIdx.x, WGM_NARROW);
                    pg8::EpiProj E{big, rstat, cosT, sinT, smask, lds};
                    pg8::gemm_phase<pg8::EpiProj, pg8::StaticOrder, true, true>(lds, g, S, E, wave0);
                }
                if (side && !oddwg) { TIDS(); phase_residual(xb_all + (size_t)HROWS * DM, fout, A.in[24] + (l - 1) * DM, rstat_all + HROWS, nullptr, lane, wave); phase_convert(A, l, lds, tid, lane, wave, 19456, 25088, 0); }
                GRID_BAR();
            }
            {
                TIDS(); LruP P; P.conv_w = A.in[5] + l * 4 * 1024; P.conv_b = A.in[6] + l * 1024;
                P.ba[0] = A.in[8] + l * 1024; P.bx[0] = A.in[10] + l * 1024; P.lam[0] = A.in[11] + l * 1024;
                P.ba[1] = A.in[13] + l * 1024; P.bx[1] = A.in[15] + l * 1024; P.lam[1] = A.in[16] + l * 1024;
                for (int ck = blockIdx.x; ck < 256; ck += gridDim.x) {
                    l1_unit(lds, big, (const bf16_t*)(ws + WS_WLRU), lbuf, agg, P, ck, smask, tid);
                    b1_chunk(lds, big, st, ck, tid);
                }
                GRID_BAR();
            }
            { TIDS(); phase_scans(st, agg, carry, nseq, Nc, tid); GRID_BAR(); }
            {
                TIDS();
                for (int ck = blockIdx.x; ck < 256; ck += gridDim.x) b3_chunk(lds, big, st, mixb, A.in[4] + l * 1024, ck, tid);
                l3_rows(big, lbuf, carry, A.in[17] + l * 1024, mixb, lane, wave);
                GRID_BAR();
            }
        }
        {
            if (more && oddwg) { TIDS(); phase_convert(A, l + 1, lds, tid, lane, wave, 0, 6144, 0); phase_convert(A, l + 1, lds, tid, lane, wave, 25088, 25344, 0); __syncthreads(); }
            pg8::Gemm g{mix_all, (const bf16_t*)(ws + WS_WOUT), 2 * HROWS, DM, DM}; pg8::StaticOrder S; S.init(2 * HROWS, DM, (int)gridDim.x, (int)blockIdx.x, WGM_NARROW);
            pg8::EpiBf16 E{big, DM};
            pg8::gemm_phase<pg8::EpiBf16, pg8::StaticOrder, true, true>(lds, g, S, E, wave0);
            if (more && !oddwg) { TIDS(); phase_convert(A, l + 1, lds, tid, lane, wave, 0, 6144, 0); phase_convert(A, l + 1, lds, tid, lane, wave, 25088, 25344, 0); }
            GRID_BAR();
        }
        { TIDS(); phase_residual(xb_all, big, A.in[19] + l * DM, rstat_all, nullptr, lane, wave, 2 * HROWS); GRID_BAR(); }
        for (int h = 0; h < 2; ++h) {
            bf16_t* xb = xb_all + (size_t)h * HROWS * DM; float* rstat = rstat_all + h * HROWS;
            {
                pg8::Gemm g{xb, (const bf16_t*)(ws + WS_WGU), HROWS, 2 * DFF, DM}; pg8::StaticOrder S; S.init(HROWS, 2 * DFF, (int)gridDim.x, (int)blockIdx.x, WGM_NARROW);
                pg8::EpiSwiGLU E{big, rstat, lds};
                float* xf0 = more ? nullptr : A.out;
                if (oddwg) { TIDS(); if (h == 0) { if (more) phase_convert(A, l + 1, lds, tid, lane, wave, 6144, 8192, 0); } else phase_residual(xb_all, fout, A.in[24] + l * DM, rstat_all, xf0, lane, wave); __syncthreads(); }
                pg8::gemm_phase<pg8::EpiSwiGLU, pg8::StaticOrder, true, true>(lds, g, S, E, wave0);
                if (!oddwg) { TIDS(); if (h == 0) { if (more) phase_convert(A, l + 1, lds, tid, lane, wave, 6144, 8192, 0); } else phase_residual(xb_all, fout, A.in[24] + l * DM, rstat_all, xf0, lane, wave); }
                GRID_BAR();
            }
            {
                pg8::Gemm g{big, (const bf16_t*)(ws + WS_WDN), HROWS, DM, DFF}; pg8::StaticOrder S; S.init(HROWS, DM, (int)gridDim.x, (int)blockIdx.x, WGM_NARROW);
                pg8::EpiBf16 E{fout, DM};
                const bool cvt = (h == 1 && more);
                if (cvt && oddwg) { TIDS(); phase_convert(A, l + 1, lds, tid, lane, wave, 8192, 19456, 0); __syncthreads(); }
                pg8::gemm_phase<pg8::EpiBf16, pg8::StaticOrder, true, true>(lds, g, S, E, wave0);
                if (cvt && !oddwg) { TIDS(); phase_convert(A, l + 1, lds, tid, lane, wave, 8192, 19456, 0); }
                GRID_BAR();
            }
        }
    }
    {
        TIDS(); phase_residual(xb_all + (size_t)HROWS * DM, fout, A.in[24] + (DEPTH - 1) * DM, rstat_all + HROWS, A.out + (size_t)HROWS * DM, lane, wave);
    }
#undef IN
#undef GRID_BAR
}

extern "C" void kernel_launch(void* const* d_in, const int* in_sizes, int n_in, void* d_out, int out_size, void* d_ws, size_t ws_size, hipStream_t stream) {
    static int grid = 0;
    if (grid == 0) {
        if (n_in != 25 || ws_size < WS_END || out_size != 2 * HROWS * DM) { fprintf(stderr, "kernel_launch: unexpected shapes (n_in %d, out %d, ws %zu; need ws >= %zu); nothing launched\n", n_in, out_size, ws_size, (size_t)WS_END); grid = -1; return; }
        int dev = 0, cus = 0, per_cu = 0;
        if (hipGetDevice(&dev) != hipSuccess || hipDeviceGetAttribute(&cus, hipDeviceAttributeMultiprocessorCount, dev) != hipSuccess) { grid = -1; return; }
        if (hipFuncSetAttribute((const void*)hymba_fwd, hipFuncAttributeMaxDynamicSharedMemorySize, LDS_BYTES) != hipSuccess) { fprintf(stderr, "kernel_launch: hipFuncSetAttribute failed\n"); grid = -1; return; }
        if (hipOccupancyMaxActiveBlocksPerMultiprocessor(&per_cu, (const void*)hymba_fwd, NTHR, LDS_BYTES) != hipSuccess || per_cu < 1) { fprintf(stderr, "kernel_launch: occupancy query reports %d blocks per CU\n", per_cu); (void)hipGetLastError(); grid = -1; return; }
        grid = cus;
    }
    if (grid < 0) return;
    (void)hipMemsetAsync((char*)d_ws + WS_CTL, 0, CTL_ZERO_BYTES, stream);
    Args a{};
    for (int i = 0; i < 25; ++i) a.in[i] = (const float*)d_in[i];
    a.out = (float*)d_out; a.ws = (unsigned char*)d_ws; a.pad = 0;
#if MK_ONE_LAUNCH
    a.l_lo = 0; a.l_hi = DEPTH; a.h_lo = 0; a.h_hi = 2; a.p_lo = 0; a.p_hi = NPH; a.use_bar = 1;
    hipLaunchKernelGGL(hymba_fwd, dim3(grid), dim3(NTHR), LDS_BYTES, stream, a);
#else
    a.use_bar = 0;
    for (int l = 0; l < DEPTH; ++l) for (int h = 0; h < 2; ++h) for (int p = (h == 0 ? 0 : 1); p < NPH; ++p) {
        a.l_lo = l; a.l_hi = l + 1; a.h_lo = h; a.h_hi = h + 1; a.p_lo = p; a.p_hi = p + 1;
        hipLaunchKernelGGL(hymba_fwd, dim3(grid), dim3(NTHR), LDS_BYTES, stream, a);
    }
#endif
}
```
